# Optimizing an MI355X kernel written in HIP

```python
import math
import jax, jax.numpy as jnp
from jax import lax
import numpy as np

D_MODEL = 1024
BATCH = 8
SEQ = 4096
DEPTH = 1

HEAD_DIM = 64
N_HEADS_DIL = 8
N_HEADS_SB = 8
D_DIL = N_HEADS_DIL * HEAD_DIM
D_SB = N_HEADS_SB * HEAD_DIM
D_MIX = D_DIL + D_SB
D_IN = 3 * D_DIL + 3 * D_SB
D_FF = -(-(8 * D_MODEL) // (3 * 256)) * 256
DILATED_PAIRS = ((128, 1), (512, 4), (2048, 16))
BLOCK = 128
ROPE_THETA = 10000.0
EPS = 1e-6

kernel_name = "hymba_dilated_stickbreaking_block"


def _rmsnorm(x, w):
    xf = x.astype(jnp.float32)
    y = xf * lax.rsqrt(jnp.mean(xf * xf, axis=-1, keepdims=True) + EPS)
    wb = w.astype(jnp.float32).reshape((1,) * (x.ndim - 1) + (w.shape[-1],))
    return (y * wb).astype(x.dtype)


def _rope_tables(seq_len):
    pos = jnp.arange(seq_len, dtype=jnp.float32)
    inv_freq = ROPE_THETA ** (-jnp.arange(0, HEAD_DIM, 2, dtype=jnp.float32) / HEAD_DIM)
    ang = pos[:, None] * inv_freq[None, :]
    return jnp.cos(ang)[None, None], jnp.sin(ang)[None, None]


def _apply_rope(x, cos, sin):
    xf = x.astype(jnp.float32)
    half = HEAD_DIM // 2
    x1, x2 = xf[..., :half], xf[..., half:]
    out = jnp.concatenate([x1 * cos - x2 * sin, x2 * cos + x1 * sin], axis=-1)
    return out.astype(x.dtype)


def _dilated_branch(q, k, v, window, dilation):
    B, H, S, Dh = q.shape
    r = dilation
    n_back = window // dilation
    L = S // r
    nb = -(-L // BLOCK)
    Lp = nb * BLOCK

    def strided(t):
        t = t.reshape(B, H, L, r, Dh).transpose(0, 1, 3, 2, 4)
        t = jnp.pad(t, ((0, 0), (0, 0), (0, 0), (0, Lp - L), (0, 0)))
        return t.reshape(B, H, r, nb, BLOCK, Dh)

    qb, kb, vb = strided(q), strided(k), strided(v)

    def with_prev(t):
        prev = jnp.pad(t, ((0, 0), (0, 0), (0, 0), (1, 0), (0, 0), (0, 0)))[:, :, :, :-1]
        return jnp.concatenate([prev, t], axis=-2)

    kk, vv = with_prev(kb), with_prev(vb)
    s = jnp.einsum('bhrnqd,bhrnkd->bhrnqk', qb, kk,
                   preferred_element_type=jnp.float32) * (Dh ** -0.5)
    i = jnp.arange(BLOCK)[:, None]
    j = jnp.arange(2 * BLOCK)[None, :]
    dist = i + BLOCK - j
    key_idx = (jnp.arange(nb)[:, None, None] - 1) * BLOCK + j[None]
    valid = (dist >= 0)[None] & (dist <= n_back)[None] & (key_idx >= 0)
    s = jnp.where(valid[None, None, None], s, -jnp.inf)
    m = jnp.max(s, axis=-1, keepdims=True)
    p = jnp.exp(s - m)
    den = jnp.sum(p, axis=-1, keepdims=True)
    o = jnp.einsum('bhrnqk,bhrnkd->bhrnqd', p.astype(v.dtype), vv,
                   preferred_element_type=jnp.float32) / den
    lse = (m + jnp.log(den))[..., 0]

    o = o.reshape(B, H, r, Lp, Dh)[:, :, :, :L].transpose(0, 1, 3, 2, 4).reshape(B, H, S, Dh)
    lse = lse.reshape(B, H, r, Lp)[:, :, :, :L].transpose(0, 1, 3, 2).reshape(B, H, S)
    return o, lse


def _dilated_attention(q, k, v):
    outs, lses = [], []
    for window, dilation in DILATED_PAIRS:
        o, lse = _dilated_branch(q, k, v, window, dilation)
        outs.append(o)
        lses.append(lse)
    w = jax.nn.softmax(jnp.stack(lses, axis=0), axis=0)
    o = jnp.sum(w[..., None] * jnp.stack(outs, axis=0), axis=0)
    return o.astype(q.dtype)


def _stick_breaking(q, k, v):
    B, H, S, Dh = q.shape
    nb = S // BLOCK
    scale = Dh ** -0.5
    qblocks = q.reshape(B, H, nb, BLOCK, Dh).transpose(2, 0, 1, 3, 4)
    kpos = jnp.arange(S)

    def one_block(args):
        qblk, bidx = args
        z = jnp.einsum('bhqd,bhkd->bhqk', qblk, k,
                       preferred_element_type=jnp.float32) * scale
        qpos = bidx * BLOCK + jnp.arange(BLOCK)
        causal = (kpos[None, :] < qpos[:, None])[None, None]
        log_beta = jax.nn.log_sigmoid(z)
        log_keep = jnp.where(causal, jax.nn.log_sigmoid(-z), 0.0)
        suffix = lax.cumsum(log_keep, axis=3, reverse=True) - log_keep
        a = jnp.where(causal, jnp.exp(log_beta + suffix), 0.0)
        return jnp.einsum('bhqk,bhkd->bhqd', a.astype(v.dtype), v,
                          preferred_element_type=jnp.float32).astype(v.dtype)

    out = lax.map(one_block, (qblocks, jnp.arange(nb)))
    return out.transpose(1, 2, 0, 3, 4).reshape(B, H, S, Dh)


def setup_inputs(seed: int = 0) -> dict:
    key = jax.random.key(seed)
    ks = jax.random.split(key, 12)
    f32 = jnp.float32

    def gain(k, n):
        return (1.0 + 0.02 * jax.random.normal(k, (DEPTH, n))).astype(f32)

    return {
        "x": jax.random.normal(ks[0], (BATCH, SEQ, D_MODEL), f32),
        "attn_norm_w": gain(ks[1], D_MODEL),
        "w_in": jax.random.normal(ks[2], (DEPTH, D_MODEL, D_IN), f32) * D_MODEL ** -0.5,
        "q_norm_w": gain(ks[3], HEAD_DIM),
        "k_norm_w": gain(ks[4], HEAD_DIM),
        "dil_out_norm_w": gain(ks[5], D_DIL),
        "sb_out_norm_w": gain(ks[6], D_SB),
        "w_out": jax.random.normal(ks[7], (DEPTH, D_MIX, D_MODEL), f32) * D_MIX ** -0.5,
        "ffn_norm_w": gain(ks[8], D_MODEL),
        "w_gate": jax.random.normal(ks[9], (DEPTH, D_MODEL, D_FF), f32) * D_MODEL ** -0.5,
        "w_up": jax.random.normal(ks[10], (DEPTH, D_MODEL, D_FF), f32) * D_MODEL ** -0.5,
        "w_down": jax.random.normal(ks[11], (DEPTH, D_FF, D_MODEL), f32) * D_FF ** -0.5,
    }


def reference(x, attn_norm_w, w_in, q_norm_w, k_norm_w, dil_out_norm_w, sb_out_norm_w,
              w_out, ffn_norm_w, w_gate, w_up, w_down):
    B, S, _ = x.shape
    cos, sin = _rope_tables(S)

    def heads(t, n):
        return t.reshape(B, S, n, HEAD_DIM).transpose(0, 2, 1, 3)

    def merge(t):
        return t.transpose(0, 2, 1, 3).reshape(B, S, t.shape[1] * t.shape[3])

    for l in range(DEPTH):
        h = _rmsnorm(x, attn_norm_w[l])
        proj = jnp.einsum('bsd,de->bse', h, w_in[l])
        qa = proj[..., 0:D_DIL]
        ka = proj[..., D_DIL:2 * D_DIL]
        va = proj[..., 2 * D_DIL:3 * D_DIL]
        o0 = 3 * D_DIL
        qs = proj[..., o0:o0 + D_SB]
        ksb = proj[..., o0 + D_SB:o0 + 2 * D_SB]
        vs = proj[..., o0 + 2 * D_SB:o0 + 3 * D_SB]

        qa = _apply_rope(_rmsnorm(heads(qa, N_HEADS_DIL), q_norm_w[l]), cos, sin)
        ka = _apply_rope(_rmsnorm(heads(ka, N_HEADS_DIL), k_norm_w[l]), cos, sin)
        o_dil = _dilated_attention(qa, ka, heads(va, N_HEADS_DIL))

        o_sb = _stick_breaking(heads(qs, N_HEADS_SB), heads(ksb, N_HEADS_SB),
                               heads(vs, N_HEADS_SB))

        mixed = jnp.concatenate([_rmsnorm(merge(o_dil), dil_out_norm_w[l]),
                                 _rmsnorm(merge(o_sb), sb_out_norm_w[l])], axis=-1)
        x = x + jnp.einsum('bse,ed->bsd', mixed, w_out[l])

        h = _rmsnorm(x, ffn_norm_w[l])
        g = jnp.einsum('bsd,df->bsf', h, w_gate[l])
        u = jnp.einsum('bsd,df->bsf', h, w_up[l])
        x = x + jnp.einsum('bsf,fd->bsd', jax.nn.silu(g) * u, w_down[l])
    return x
```

```cpp
#include <hip/hip_runtime.h>
#include <hip/hip_cooperative_groups.h>
#include <cstdio>
#include <cstdint>
#include <cmath>
namespace cg = cooperative_groups;
namespace pg8 {
#define PG8_LAS __attribute__((address_space(3)))
typedef unsigned short bf16_t;
typedef short bf16x8 __attribute__((ext_vector_type(8)));
typedef float f32x4 __attribute__((ext_vector_type(4)));
typedef unsigned u32x4 __attribute__((ext_vector_type(4)));
constexpr int BM = 256, BK = 64, HALF = 128, HTB = HALF * BK * 2  , STAGE_BYTES = 8 * HTB, NXCD = 8, WGM = 2  ;

__host__ __device__ __forceinline__ int lds_byte(int r, int c) { const int st = (r >> 4) * 2 + (c >> 5), rr = r & 15, cc = c & 31, ob = rr * 64 + cc * 2; return st * 1024 + (ob ^ (((ob >> 9) & 1) << 5)); }
__host__ __device__ __forceinline__ void stage_rc(int b, int& R, int& C) { const int st = b / 1024, sb = b % 1024, swz = sb ^ (((sb >> 9) & 1) << 5); R = (st >> 1) * 16 + swz / 64; C = (st & 1) * 32 + (swz % 64) / 2; }
__host__ __device__ __forceinline__ int perm32(int rho) { const int n = rho >> 4, i = rho & 15; return 8 * (i >> 2) + 4 * n + (i & 3); }

struct Unit { int pm, pn; };
struct Gemm { const bf16_t* A; const bf16_t* Bt; int M, N, K; };

struct StaticOrder {
    int nM, nN, nwg, G, c;
    __host__ __device__ void init(int M, int N, int G_, int c_) { nM = M / BM; nN = N / BM; nwg = nM * nN; G = G_; c = c_; }
    __host__ __device__ bool next(int i, Unit& u) const {
        const long L = (long)i * G + c; if (L >= nwg) return false;
        int wgid = (int)L; { const int q = nwg / NXCD, r = nwg % NXCD, xcd = wgid % NXCD, off = wgid / NXCD; wgid = (xcd < r ? xcd * (q + 1) : r * (q + 1) + (xcd - r) * q) + off; }
        const int nig = WGM * nN, gid = wgid / nig, fm = gid * WGM, gsz = (nM - fm) < WGM ? (nM - fm) : WGM;
        u.pm = fm + ((wgid % nig) % gsz); u.pn = (wgid % nig) / gsz; return true;
    }
    __device__ __forceinline__ void a_ready(const Unit&) const {}
    __device__ __forceinline__ void done(const Unit&) const {}
};

__device__ __forceinline__ unsigned cvt_pk_bf16(float lo, float hi) { unsigned r; asm volatile("v_cvt_pk_bf16_f32 %0, %1, %2" : "=v"(r) : "v"(lo), "v"(hi)); return r; }
typedef float f32x2 __attribute__((ext_vector_type(2)));
struct EpiQKV {
    static constexpr bool PERM = true, AFTER_DRAIN = false;
    static constexpr int M_TOK = 32768;
    bf16_t* O; int ldc; int n_q, n_norm, qs_lo, qs_hi; float scale; const float* qw; const float* kw; const float* ct; const float* st; float eps;
    __device__ __forceinline__ void operator()(const f32x4 (&acc)[2][2][4][2], const Unit& u, int wr, int wc, int fr, int fq) const {
        const int row0 = u.pm * BM + wr * 64 + fr; bf16_t* const Oh = O + (size_t)(u.pn >> 1) * ((size_t)M_TOK * 512) + (size_t)(4 * (u.pn & 1) + wc) * (4096 * 64) + 8 * fq;
        if (u.pn < n_norm) {
            const bool isq = u.pn < n_q; const float* w = isq ? qw : kw; const float osc = isq ? scale : 1.f;
            const f32x4 wl0 = *(const f32x4*)(w + 8 * fq), wl1 = *(const f32x4*)(w + 8 * fq + 4), wh0 = *(const f32x4*)(w + 32 + 8 * fq), wh1 = *(const f32x4*)(w + 32 + 8 * fq + 4);
#pragma unroll
            for (int ab = 0; ab < 4; ++ab) { const int ai = ab >> 1, mb = (ab & 1) * 2;
                f32x4 tc0[4], tc1[4], ts0[4], ts1[4];
#pragma unroll
                for (int m = mb; m < mb + 2; ++m) { const int pos = (row0 + ai * HALF + m * 16) & 4095;
                    tc0[m] = *(const f32x4*)(ct + pos * 32 + 8 * fq); tc1[m] = *(const f32x4*)(ct + pos * 32 + 8 * fq + 4); ts0[m] = *(const f32x4*)(st + pos * 32 + 8 * fq); ts1[m] = *(const f32x4*)(st + pos * 32 + 8 * fq + 4); }
#pragma unroll
                for (int m = mb; m < mb + 2; ++m) { const int r = row0 + ai * HALF + m * 16; const int pos = r & 4095;
                    const f32x4 c0 = tc0[m], c1 = tc1[m], s0 = ts0[m], s1 = ts1[m];
                    const f32x4 a0 = acc[ai][0][m][0], a1 = acc[ai][0][m][1], b0 = acc[ai][1][m][0], b1 = acc[ai][1][m][1];
                    const f32x4 q2 = (a0 * a0 + a1 * a1) + (b0 * b0 + b1 * b1); float ss = (q2[0] + q2[1]) + (q2[2] + q2[3]);
                    ss += __shfl_xor(ss, 16); ss += __shfl_xor(ss, 32);
                    const float rs = __builtin_amdgcn_rsqf(ss * (1.f / 64.f) + eps) * osc;
                    const f32x4 yl0 = a0 * rs * wl0, yl1 = a1 * rs * wl1, yh0 = b0 * rs * wh0, yh1 = b1 * rs * wh1;
                    const f32x4 ol0 = yl0 * c0 - yh0 * s0, ol1 = yl1 * c1 - yh1 * s1, oh0 = yh0 * c0 + yl0 * s0, oh1 = yh1 * c1 + yl1 * s1;
                    bf16_t* rowp = Oh + ((size_t)(r >> 12) * (8 * 4096) + (size_t)pos) * 64;
                    u32x4 wv; wv.x = cvt_pk_bf16(ol0[0], ol0[1]); wv.y = cvt_pk_bf16(ol0[2], ol0[3]); wv.z = cvt_pk_bf16(ol1[0], ol1[1]); wv.w = cvt_pk_bf16(ol1[2], ol1[3]); *(u32x4*)rowp = wv;
                    wv.x = cvt_pk_bf16(oh0[0], oh0[1]); wv.y = cvt_pk_bf16(oh0[2], oh0[3]); wv.z = cvt_pk_bf16(oh1[0], oh1[1]); wv.w = cvt_pk_bf16(oh1[2], oh1[3]); *(u32x4*)(rowp + 32) = wv; }
            }
        } else {
            const float sc = (u.pn >= qs_lo && u.pn <= qs_hi) ? scale : 1.f;
#pragma unroll
            for (int ai = 0; ai < 2; ++ai)
#pragma unroll
                for (int m = 0; m < 4; ++m) { const int r = row0 + ai * HALF + m * 16; bf16_t* rowp = Oh + ((size_t)(r >> 12) * (8 * 4096) + (size_t)(r & 4095)) * 64;
#pragma unroll
                    for (int bj = 0; bj < 2; ++bj) { const f32x4 v0 = acc[ai][bj][m][0] * sc, v1 = acc[ai][bj][m][1] * sc;
                        u32x4 w; w.x = cvt_pk_bf16(v0[0], v0[1]); w.y = cvt_pk_bf16(v0[2], v0[3]); w.z = cvt_pk_bf16(v1[0], v1[1]); w.w = cvt_pk_bf16(v1[2], v1[3]);
                        *(u32x4*)(rowp + bj * 32) = w; } }
        }
    }
};
struct EpiRes1 {
    static constexpr bool PERM = true, AFTER_DRAIN = false;
    const float* base; bf16_t* xn; float* ssq; int ldc;
    __device__ __forceinline__ void operator()(const f32x4 (&acc)[2][2][4][2], const Unit& u, int wr, int wc, int fr, int fq) const {
        const int col0 = u.pn * BM + wc * 32 + 8 * fq;
#pragma unroll
        for (int ab = 0; ab < 4; ++ab) { const int ai = ab >> 1, mb = (ab & 1) * 2;
            f32x4 bx[4][2][2];
#pragma unroll
            for (int m = mb; m < mb + 2; ++m) { const size_t off = (size_t)(u.pm * BM + ai * HALF + wr * 64 + m * 16 + fr) * ldc + col0;
#pragma unroll
                for (int bj = 0; bj < 2; ++bj) { bx[m][bj][0] = *(const f32x4*)(base + off + bj * HALF); bx[m][bj][1] = *(const f32x4*)(base + off + bj * HALF + 4); } }
#pragma unroll
            for (int m = mb; m < mb + 2; ++m) { const int r = u.pm * BM + ai * HALF + wr * 64 + m * 16 + fr; const size_t off = (size_t)r * ldc + col0; float ss = 0.f;
#pragma unroll
                for (int bj = 0; bj < 2; ++bj) { const f32x4 v0 = bx[m][bj][0] + acc[ai][bj][m][0], v1 = bx[m][bj][1] + acc[ai][bj][m][1];
                    u32x4 w; w.x = cvt_pk_bf16(v0[0], v0[1]); w.y = cvt_pk_bf16(v0[2], v0[3]); w.z = cvt_pk_bf16(v1[0], v1[1]); w.w = cvt_pk_bf16(v1[2], v1[3]); *(u32x4*)(xn + off + bj * HALF) = w;
                    ss += ((v0[0] * v0[0] + v0[1] * v0[1]) + (v0[2] * v0[2] + v0[3] * v0[3])) + ((v1[0] * v1[0] + v1[1] * v1[1]) + (v1[2] * v1[2] + v1[3] * v1[3])); }
                ss += __shfl_xor(ss, 16); ss += __shfl_xor(ss, 32);
                if (fq == 0) ssq[(size_t)r * 16 + u.pn * 4 + wc] = ss; }
        }
    }
};
struct EpiSwiGLU {
    static constexpr bool PERM = true, AFTER_DRAIN = false;
    bf16_t* O; int ldc; const float* ssq; float inv_d, eps;
    __device__ __forceinline__ void operator()(const f32x4 (&acc)[2][2][4][2], const Unit& u, int wr, int wc, int fr, int fq) const {
        const int row0 = u.pm * BM + wr * 64 + fr, col0 = u.pn * HALF + wc * 32 + 8 * fq;
        f32x4 sq[2][4];
#pragma unroll
        for (int ai = 0; ai < 2; ++ai)
#pragma unroll
            for (int m = 0; m < 4; ++m) sq[ai][m] = *(const f32x4*)(ssq + (size_t)(row0 + ai * HALF + m * 16) * 16 + 4 * fq);
#pragma unroll
        for (int ai = 0; ai < 2; ++ai)
#pragma unroll
            for (int m = 0; m < 4; ++m) { const int r = row0 + ai * HALF + m * 16;
                float t = (sq[ai][m][0] + sq[ai][m][1]) + (sq[ai][m][2] + sq[ai][m][3]); t += __shfl_xor(t, 16); t += __shfl_xor(t, 32);
                const float rs = __builtin_amdgcn_rsqf(t * inv_d + eps);
                float a[8];
#pragma unroll
                for (int n = 0; n < 2; ++n)
#pragma unroll
                    for (int i = 0; i < 4; ++i) { const float g = acc[ai][0][m][n][i] * rs, uu = acc[ai][1][m][n][i] * rs;
                        a[n * 4 + i] = g * __builtin_amdgcn_rcpf(1.f + __builtin_amdgcn_exp2f(-1.4426950408889634f * g)) * uu; }
                u32x4 w; w.x = cvt_pk_bf16(a[0], a[1]); w.y = cvt_pk_bf16(a[2], a[3]); w.z = cvt_pk_bf16(a[4], a[5]); w.w = cvt_pk_bf16(a[6], a[7]);
                *(u32x4*)(O + (size_t)r * ldc + col0) = w; }
    }
};
struct EpiRes2 {
    static constexpr bool PERM = true, AFTER_DRAIN = false;
    const bf16_t* xn; float* out; int ldc;
    __device__ __forceinline__ void operator()(const f32x4 (&acc)[2][2][4][2], const Unit& u, int wr, int wc, int fr, int fq) const {
        const int col0 = u.pn * BM + wc * 32 + 8 * fq;
#pragma unroll
        for (int ai = 0; ai < 2; ++ai) {
            u32x4 xv[4][2];
#pragma unroll
            for (int m = 0; m < 4; ++m) { const size_t off = (size_t)(u.pm * BM + ai * HALF + wr * 64 + m * 16 + fr) * ldc + col0;
                xv[m][0] = *(const u32x4*)(xn + off); xv[m][1] = *(const u32x4*)(xn + off + HALF); }
#pragma unroll
            for (int m = 0; m < 4; ++m) { const size_t off = (size_t)(u.pm * BM + ai * HALF + wr * 64 + m * 16 + fr) * ldc + col0;
#pragma unroll
                for (int bj = 0; bj < 2; ++bj) { const u32x4 w = xv[m][bj];
                    f32x4 b0, b1; b0[0] = __builtin_bit_cast(float, w.x << 16); b0[1] = __builtin_bit_cast(float, w.x & 0xffff0000u); b0[2] = __builtin_bit_cast(float, w.y << 16); b0[3] = __builtin_bit_cast(float, w.y & 0xffff0000u);
                    b1[0] = __builtin_bit_cast(float, w.z << 16); b1[1] = __builtin_bit_cast(float, w.z & 0xffff0000u); b1[2] = __builtin_bit_cast(float, w.w << 16); b1[3] = __builtin_bit_cast(float, w.w & 0xffff0000u);
                    *(f32x4*)(out + off + bj * HALF) = b0 + acc[ai][bj][m][0]; *(f32x4*)(out + off + bj * HALF + 4) = b1 + acc[ai][bj][m][1]; } }
        }
    }
};
template <class Epi, class Sched, bool ALIGN_EPI = false, bool SP2 = false>
__device__ __forceinline__ void gemm_phase(PG8_LAS unsigned char* lds, const Gemm g, const Sched& S, const Epi& E) {
    const int tid = threadIdx.x, wid = __builtin_amdgcn_readfirstlane(tid >> 6), lane = tid & 63, wr = wid >> 2, wc = wid & 3, fr = lane & 15, fq = lane >> 4;
    const int K = g.K, nt = K / BK;
    unsigned voffA[2], voffB[2];
#pragma unroll
    for (int i = 0; i < 2; ++i) { int R, C; stage_rc(tid * 16 + i * 8192, R, C); const int Rb = Epi::PERM ? ((R & ~31) + perm32(R & 31)) : R;
        voffA[i] = (unsigned)(R * K + C) * 2u; voffB[i] = (unsigned)(Rb * K + C) * 2u; }
    const size_t kstep = (size_t)(BK * 2);
    const size_t hstep = (size_t)HALF * K * 2;
    const size_t tstep = 2 * hstep;
    const unsigned ldsw = (unsigned)wid * 1024u;
    const int aoff = lds_byte(wr * 64 + fr, fq * 8), boff = lds_byte(wc * 32 + fr, fq * 8);
#define PG8_SA(b, h) (((b) * 2 + (h)) * HTB)
#define PG8_SB(b, h) ((4 + (b) * 2 + (h)) * HTB)
#define PG8_STAGE(bufoff, gbase, voff) do { _Pragma("unroll") for (int _i = 0; _i < 2; ++_i) \
        __builtin_amdgcn_global_load_lds((const unsigned*)((const char*)(gbase) + (voff)[_i]), (PG8_LAS unsigned*)(lds + (bufoff) + ldsw + _i * 8192), 16, 0, 0); } while (0)
#define PG8_LDA(dst, b, h) do { _Pragma("unroll") for (int m = 0; m < 4; ++m) _Pragma("unroll") for (int k = 0; k < 2; ++k) dst[m][k] = *(const PG8_LAS bf16x8*)(lds + PG8_SA(b, h) + aoff + m * 2048 + k * 1024); } while (0)
#define PG8_LDB(dst, b, h) do { _Pragma("unroll") for (int n = 0; n < 2; ++n) _Pragma("unroll") for (int k = 0; k < 2; ++k) dst[n][k] = *(const PG8_LAS bf16x8*)(lds + PG8_SB(b, h) + boff + n * 2048 + k * 1024); } while (0)
#define PG8_MMA(ai, bj, At, Bt) do { __builtin_amdgcn_s_setprio(1); _Pragma("unroll") for (int m = 0; m < 4; ++m) _Pragma("unroll") for (int n = 0; n < 2; ++n) _Pragma("unroll") for (int k = 0; k < 2; ++k) \
        acc[ai][bj][m][n] = __builtin_amdgcn_mfma_f32_16x16x32_bf16(Bt[n][k], At[m][k], acc[ai][bj][m][n], 0, 0, 0); __builtin_amdgcn_s_setprio(0); } while (0)
#define PG8_WAIT_V(n) asm volatile("s_waitcnt vmcnt(" #n ")" ::: "memory")
#define PG8_WAIT_L(n) asm volatile("s_waitcnt lgkmcnt(" #n ")" ::: "memory")
#define PG8_BAR __builtin_amdgcn_s_barrier()
#define PG8_SCHED __builtin_amdgcn_sched_barrier(0)
    Unit cur, nxt; int ui = 0;
    if (!S.next(0, cur)) return;
    f32x4 acc[2][2][4][2];
#pragma unroll
    for (int a = 0; a < 2; ++a)
#pragma unroll
        for (int b = 0; b < 2; ++b)
#pragma unroll
            for (int m = 0; m < 4; ++m)
#pragma unroll
                for (int n = 0; n < 2; ++n) acc[a][b][m][n] = (f32x4){0.f, 0.f, 0.f, 0.f};
    bf16x8 At[4][2], B0[2][2], B1[2][2];
    const char* cA = (const char*)g.A + (size_t)cur.pm * tstep; const char* cB = (const char*)g.Bt + (size_t)cur.pn * tstep;
    S.a_ready(cur);
    if constexpr (SP2) {
        PG8_STAGE(PG8_SB(0, 0), cB, voffB); PG8_STAGE(PG8_SB(0, 1), cB + hstep, voffB); PG8_STAGE(PG8_SA(0, 0), cA, voffA); PG8_STAGE(PG8_SA(0, 1), cA + hstep, voffA);
        if (wr == 1) PG8_BAR;
        PG8_WAIT_V(2); PG8_BAR;
        PG8_STAGE(PG8_SB(1, 0), cB + kstep, voffB); PG8_STAGE(PG8_SA(1, 0), cA + kstep, voffA); PG8_STAGE(PG8_SB(1, 1), cB + hstep + kstep, voffB);
        PG8_WAIT_V(6); PG8_BAR;
    } else {
        PG8_STAGE(PG8_SB(0, 0), cB, voffB); PG8_STAGE(PG8_SA(0, 0), cA, voffA); PG8_STAGE(PG8_SB(0, 1), cB + hstep, voffB); PG8_STAGE(PG8_SA(0, 1), cA + hstep, voffA);
        if (wr == 1) PG8_BAR;
        PG8_WAIT_V(4); PG8_BAR;
        PG8_STAGE(PG8_SB(1, 0), cB + kstep, voffB); PG8_STAGE(PG8_SA(1, 0), cA + kstep, voffA); PG8_STAGE(PG8_SB(1, 1), cB + hstep + kstep, voffB);
        PG8_WAIT_V(6); PG8_BAR;
    }
    for (;;) {
        const bool has_next = S.next(ui + 1, nxt);
        const char* nA = has_next ? (const char*)g.A + (size_t)nxt.pm * tstep : cA; const char* nB = has_next ? (const char*)g.Bt + (size_t)nxt.pn * tstep : cB;
        for (int t = 0; t < nt; t += 2) {
            const bool last = (t == nt - 2);
            const char* a1 = cA + (size_t)(t + 1) * kstep;
            const char* a2 = last ? nA : cA + (size_t)(t + 2) * kstep; const char* b2 = last ? nB : cB + (size_t)(t + 2) * kstep;
            const char* a3 = a2 + kstep; const char* b3 = b2 + kstep;
            if (last && has_next) S.a_ready(nxt);
            if constexpr (SP2) {
            PG8_LDB(B0, 0, 0); PG8_LDB(B1, 0, 1); PG8_SCHED; PG8_LDA(At, 0, 0); PG8_STAGE(PG8_SA(1, 1), a1 + hstep, voffA);
            PG8_WAIT_V(8); PG8_WAIT_L(0); PG8_BAR; PG8_MMA(0, 0, At, B0); PG8_MMA(0, 1, At, B1); PG8_BAR; PG8_SCHED;
            PG8_LDA(At, 0, 1); PG8_STAGE(PG8_SB(0, 0), b2, voffB); PG8_STAGE(PG8_SB(0, 1), b2 + hstep, voffB); PG8_STAGE(PG8_SA(0, 0), a2, voffA);
            PG8_WAIT_V(8); PG8_WAIT_L(0); PG8_BAR; PG8_MMA(1, 0, At, B0); PG8_MMA(1, 1, At, B1); PG8_BAR; PG8_SCHED;
            PG8_LDB(B0, 1, 0); PG8_LDB(B1, 1, 1); PG8_SCHED; PG8_LDA(At, 1, 0); PG8_STAGE(PG8_SA(0, 1), a2 + hstep, voffA);
            PG8_WAIT_V(8); PG8_WAIT_L(0); PG8_BAR; PG8_MMA(0, 0, At, B0); PG8_MMA(0, 1, At, B1); PG8_BAR; PG8_SCHED;
            PG8_LDA(At, 1, 1); PG8_STAGE(PG8_SB(1, 0), b3, voffB); PG8_STAGE(PG8_SB(1, 1), b3 + hstep, voffB); PG8_STAGE(PG8_SA(1, 0), a3, voffA);
            PG8_WAIT_V(8); PG8_WAIT_L(0); PG8_BAR; PG8_MMA(1, 0, At, B0); PG8_MMA(1, 1, At, B1); PG8_BAR; PG8_SCHED;
            } else {
            PG8_LDB(B0, 0, 0); PG8_SCHED; PG8_LDA(At, 0, 0); PG8_STAGE(PG8_SA(1, 1), a1 + hstep, voffA);
            PG8_WAIT_L(8); PG8_BAR; PG8_WAIT_L(0); PG8_MMA(0, 0, At, B0); PG8_BAR; PG8_SCHED;
            PG8_LDB(B1, 0, 1); PG8_STAGE(PG8_SB(0, 0), b2, voffB);
            PG8_BAR; PG8_WAIT_L(0); PG8_MMA(0, 1, At, B1); PG8_BAR;
            PG8_LDA(At, 0, 1); PG8_STAGE(PG8_SA(0, 0), a2, voffA);
            PG8_BAR; PG8_WAIT_L(0); PG8_MMA(1, 0, At, B0); PG8_BAR; PG8_SCHED;
            PG8_STAGE(PG8_SB(0, 1), b2 + hstep, voffB);
            PG8_WAIT_V(6); PG8_BAR; PG8_MMA(1, 1, At, B1); PG8_BAR;
            PG8_LDB(B0, 1, 0); PG8_SCHED; PG8_LDA(At, 1, 0); PG8_STAGE(PG8_SA(0, 1), a2 + hstep, voffA);
            PG8_WAIT_L(8); PG8_BAR; PG8_WAIT_L(0); PG8_MMA(0, 0, At, B0); PG8_BAR; PG8_SCHED;
            PG8_LDB(B1, 1, 1); PG8_STAGE(PG8_SB(1, 0), b3, voffB);
            PG8_BAR; PG8_WAIT_L(0); PG8_MMA(0, 1, At, B1); PG8_BAR;
            PG8_LDA(At, 1, 1); PG8_STAGE(PG8_SA(1, 0), a3, voffA);
            PG8_BAR; PG8_WAIT_L(0); PG8_MMA(1, 0, At, B0); PG8_BAR; PG8_SCHED;
            PG8_STAGE(PG8_SB(1, 1), b3 + hstep, voffB);
            PG8_WAIT_V(6); PG8_BAR; PG8_MMA(1, 1, At, B1); PG8_BAR;
            }
        }
        if constexpr (ALIGN_EPI) { if (wr == 0) PG8_BAR; }
        if constexpr (!Epi::AFTER_DRAIN) { E(acc, cur, wr, wc, fr, fq); S.done(cur); }
        if (!has_next) break;
#pragma unroll
        for (int a = 0; a < 2; ++a)
#pragma unroll
            for (int b = 0; b < 2; ++b)
#pragma unroll
                for (int m = 0; m < 4; ++m)
#pragma unroll
                    for (int n = 0; n < 2; ++n) acc[a][b][m][n] = (f32x4){0.f, 0.f, 0.f, 0.f};
        cur = nxt; cA = nA; cB = nB; ++ui;
        if constexpr (ALIGN_EPI) { if (wr == 1) PG8_BAR; }
    }
    PG8_WAIT_V(0);
    if constexpr (!ALIGN_EPI) { if (wr == 0) PG8_BAR; }
    PG8_BAR;
    if constexpr (Epi::AFTER_DRAIN) { E.fused(acc, cur, wr, wc, fr, fq, lds, wid, lane); S.done(cur); }
#undef PG8_SA
#undef PG8_SB
#undef PG8_STAGE
#undef PG8_LDA
#undef PG8_LDB
#undef PG8_MMA
#undef PG8_WAIT_V
#undef PG8_WAIT_L
#undef PG8_BAR
#undef PG8_SCHED
}
}

constexpr int BATCH = 8, SEQ = 4096, DM = 1024, TOK = BATCH * SEQ, DIN = 3072, DFF = 2816, NH = 8, HD = 64;
constexpr float EPS = 1e-6f;
constexpr float QSCALE = 0.125f * 1.4426950408889634f;
constexpr int C_QA = 0, C_KA = 512, C_VA = 1024, C_QS = 1536, C_KS = 2048, C_VS = 2560;
constexpr size_t SLAB = (size_t)TOK * 512;

constexpr size_t MiB = 1u << 20;
constexpr size_t WS_CTL = 0;
constexpr size_t WS_WIN = 1 * MiB, WS_WOUT = 7 * MiB, WS_WGU = 9 * MiB, WS_WD = 20 * MiB;
constexpr size_t WS_ROPE = 26 * MiB;
constexpr size_t WS_SSQ = 27 * MiB;
constexpr size_t WS_LSE = 29 * MiB;
constexpr size_t WS_XN = 32 * MiB;
constexpr size_t WS_QKV = 96 * MiB;
constexpr size_t WS_ACT = 96 * MiB;
constexpr size_t WS_MIX = 288 * MiB;
constexpr size_t WS_MIXN = 96 * MiB;
constexpr size_t WS_DILO = 352 * MiB;
constexpr size_t WS_END = 448 * MiB;

constexpr int NWAVES = 8;
constexpr int RING_BYTES = 131072;
constexpr int LDS_BYTES = 147456;

#define LAS __attribute__((address_space(3)))
typedef unsigned short bf16;
__device__ __forceinline__ const bf16* head_base(const bf16* QKV, int slab, int b, int h) { return QKV + (size_t)slab * SLAB + (size_t)(b * NH + h) * (SEQ * HD); }
typedef float f32x4 __attribute__((ext_vector_type(4)));
typedef float f32x16 __attribute__((ext_vector_type(16)));
typedef short bf16x8 __attribute__((ext_vector_type(8)));
typedef short s16x4 __attribute__((ext_vector_type(4)));
typedef _Float16 f16x8 __attribute__((ext_vector_type(8)));
typedef unsigned u32x4 __attribute__((ext_vector_type(4)));
typedef unsigned u32x2 __attribute__((ext_vector_type(2)));

__device__ __forceinline__ unsigned f2bf(float f) { unsigned u = __builtin_bit_cast(unsigned, f); return (u + 0x7fffu + ((u >> 16) & 1u)) >> 16; }
__device__ __forceinline__ unsigned pk2(float lo, float hi) { return pg8::cvt_pk_bf16(lo, hi); }
__device__ __forceinline__ float bf_lo(unsigned w) { return __builtin_bit_cast(float, w << 16); }
__device__ __forceinline__ float bf_hi(unsigned w) { return __builtin_bit_cast(float, w & 0xffff0000u); }
__device__ __forceinline__ int crow(int r, int hi) { return (r & 3) + 8 * (r >> 2) + 4 * hi; }
__device__ __forceinline__ s16x4 vtr(LAS const unsigned char* p) { return __builtin_bit_cast(s16x4, __builtin_amdgcn_ds_read_tr16_b64_v4i16((LAS s16x4*)p)); }
#define MFMA_BF16(a, b, c) __builtin_amdgcn_mfma_f32_32x32x16_bf16((a), (b), (c), 0, 0, 0)
#define MFMA_F16(a, b, c) __builtin_amdgcn_mfma_f32_32x32x16_f16((a), (b), (c), 0, 0, 0)

struct Args {
    const float* x; const float* attn_norm_w; const float* w_in; const float* q_norm_w; const float* k_norm_w; const float* dil_norm_w; const float* sb_norm_w;
    const float* w_out; const float* ffn_norm_w; const float* w_gate; const float* w_up; const float* w_down;
    float* out; unsigned char* ws; int ph_lo, ph_hi;
};
#define XB_TMO      128
#define XB_XCNT(j)  (256  + 64 * (j))
#define XB_XSUB(j)  (1280 + 64 * (j))
#define XB_XGEN(j)  (2304 + 64 * (j))
#define XB_TOP      3328
#define XB_TOPGEN   3392
#define XCD_BAR_WORDS 3456
#define XB_SPIN_CAP (1u << 18)

__device__ __forceinline__ unsigned xb_ld(unsigned* p)              { return __hip_atomic_load(p, __ATOMIC_RELAXED, __HIP_MEMORY_SCOPE_AGENT); }
__device__ __forceinline__ unsigned xb_add(unsigned* p, unsigned v) { return __hip_atomic_fetch_add(p, v, __ATOMIC_RELAXED, __HIP_MEMORY_SCOPE_AGENT); }
__device__ __forceinline__ unsigned xb_xcc_id() { return (unsigned)__builtin_amdgcn_s_getreg((3 << 11) | 20) & 0xFu; }
#define XB_SPIN(cond, bar) do { unsigned _sp = 0; while (cond) { __builtin_amdgcn_s_sleep(1); \
    if ((++_sp & 255u) == 0u) { if (xb_ld(&(bar)[XB_TMO])) break; if (_sp > XB_SPIN_CAP) { atomicAdd(&(bar)[XB_TMO], 1u); break; } } } } while (0)

struct XcdBarrier {
    unsigned* bar; unsigned x;
    volatile LAS unsigned* st;
};

__device__ __forceinline__ XcdBarrier xcd_barrier_post(unsigned* bar, volatile LAS unsigned* st) {
    XcdBarrier b; b.bar = bar; b.x = xb_xcc_id(); b.st = st;
    if (threadIdx.x == 0) (void)xb_add(&bar[XB_XCNT(b.x)], 1u);
    return b;
}
__device__ __forceinline__ void xcd_barrier_complete(unsigned* bar, unsigned x, unsigned& nloc, unsigned& nx) {
    const unsigned G = gridDim.x * gridDim.y * gridDim.z;
    unsigned sum, cnt, mine, sp = 0u;
    for (;;) {
        sum = 0u; cnt = 0u; mine = 0u;
#pragma unroll
        for (unsigned j = 0; j < 16; ++j) { const unsigned c = xb_ld(&bar[XB_XCNT(j)]); sum += c; cnt += (c > 0u) ? 1u : 0u; mine = (j == x) ? c : mine; }
        if (sum == G) break;
        __builtin_amdgcn_s_sleep(1);
        if ((++sp & 255u) == 0u) { if (xb_ld(&bar[XB_TMO])) break; if (sp > XB_SPIN_CAP) { atomicAdd(&bar[XB_TMO], 1u); break; } }
    }
    nloc = mine > 0u ? mine : 1u; nx = cnt > 0u ? cnt : 1u;
}

__device__ __forceinline__ void xcd_barrier(const XcdBarrier& b) {
    asm volatile("s_waitcnt vmcnt(0)" ::: "memory");
    __syncthreads();
    if (threadIdx.x == 0) {
        unsigned* bar = b.bar;
        __builtin_amdgcn_s_waitcnt(0);
        unsigned nloc = b.st[0], nx = b.st[1];
        if (nloc == 0u) { xcd_barrier_complete(bar, b.x, nloc, nx); b.st[0] = nloc; b.st[1] = nx; }
        const unsigned old = xb_add(&bar[XB_XSUB(b.x)], 1u);
        const unsigned gen = old / nloc;
        if (old + 1u == (gen + 1u) * nloc) {
            __builtin_amdgcn_fence(__ATOMIC_RELEASE, "agent");
            asm volatile("s_waitcnt vmcnt(0)" ::: "memory");
            const unsigned og = xb_add(&bar[XB_TOP], 1u);
            const unsigned tg = og / nx;
            if (og + 1u == (tg + 1u) * nx) xb_add(&bar[XB_TOPGEN], 1u);
            else XB_SPIN(xb_ld(&bar[XB_TOPGEN]) == tg, bar);
            __builtin_amdgcn_fence(__ATOMIC_ACQUIRE, "agent");
            xb_add(&bar[XB_XGEN(b.x)], 1u);
            asm volatile("s_waitcnt vmcnt(0)" ::: "memory");
        } else {
            XB_SPIN(xb_ld(&bar[XB_XGEN(b.x)]) == gen, bar);
            __builtin_amdgcn_fence(__ATOMIC_ACQUIRE, "agent");
            asm volatile("s_waitcnt vmcnt(0)" ::: "memory");
        }
    }
    __syncthreads();
}

template <int MODE>
__device__ __forceinline__ void p0_transpose_item(const float* __restrict__ W, int K, int N, bf16* __restrict__ WT, const float* __restrict__ kscale, LAS float* scr, int item, int lane) {
    const int nblk = N / 32, kb = item / nblk, nb = item % nblk, k0 = 64 * kb, n0 = 32 * nb;
    const int c = lane & 7;
    f32x4 ks0 = {1.f, 1.f, 1.f, 1.f}, ks1 = ks0;
    if (kscale) { ks0 = *(const f32x4*)(kscale + k0 + 8 * c); ks1 = *(const f32x4*)(kscale + k0 + 8 * c + 4); }
    float wv[32];
#pragma unroll
    for (int i = 0; i < 32; ++i) wv[i] = W[(size_t)(k0 + 2 * i + (lane >> 5)) * N + n0 + (lane & 31)];
#pragma unroll
    for (int i = 0; i < 32; ++i) scr[(2 * i + (lane >> 5)) * 33 + (lane & 31)] = wv[i];
    asm volatile("s_waitcnt lgkmcnt(0)" ::: "memory");
#pragma unroll
    for (int j = 0; j < 4; ++j) { const int n = (lane >> 3) + 8 * j; const LAS float* s = scr + (8 * c) * 33 + n;
        u32x4 o; o.x = pk2(s[0 * 33] * ks0[0], s[1 * 33] * ks0[1]); o.y = pk2(s[2 * 33] * ks0[2], s[3 * 33] * ks0[3]); o.z = pk2(s[4 * 33] * ks1[0], s[5 * 33] * ks1[1]); o.w = pk2(s[6 * 33] * ks1[2], s[7 * 33] * ks1[3]);
        const int ng = n0 + n; const int row = (MODE == 0) ? ng : (MODE == 3) ? ((ng & ~255) + 128 * ((ng >> 5) & 1) + 32 * ((ng >> 6) & 3) + (ng & 31)) : (256 * (ng >> 7) + (ng & 127) + (MODE == 2 ? 128 : 0));
        *(u32x4*)(WT + (size_t)row * K + k0 + 8 * c) = o; }
    asm volatile("s_waitcnt lgkmcnt(0)" ::: "memory");
}
__device__ __forceinline__ float wave_sum(float v) {
#pragma unroll
    for (int o = 1; o < 64; o <<= 1) v += __shfl_xor(v, o);
    return v;
}
__device__ __forceinline__ void p0_prologue(const Args& A, LAS unsigned char* lds, int vcu, int G, int wave, int lane) {
    LAS float* scr = (LAS float*)(lds + wave * 16384);
    const int gw = vcu * NWAVES + wave, NGW = G * NWAVES;
    unsigned char* ws = A.ws;
    constexpr int I_IN = (DM / 64) * (DIN / 32), I_OUT = (DM / 64) * (DM / 32), I_G = (DM / 64) * (DFF / 32), I_D = (DFF / 64) * (DM / 32);
    constexpr int NITEMS = I_IN + I_OUT + 2 * I_G + I_D;
    for (int it = gw; it < NITEMS; it += NGW) {
        int r = it;
        if (r < I_IN) { p0_transpose_item<3>(A.w_in, DM, DIN, (bf16*)(ws + WS_WIN), nullptr, scr, r, lane); continue; } r -= I_IN;
        if (r < I_OUT) { p0_transpose_item<0>(A.w_out, DM, DM, (bf16*)(ws + WS_WOUT), nullptr, scr, r, lane); continue; } r -= I_OUT;
        if (r < I_G) { p0_transpose_item<1>(A.w_gate, DM, DFF, (bf16*)(ws + WS_WGU), A.ffn_norm_w, scr, r, lane); continue; } r -= I_G;
        if (r < I_G) { p0_transpose_item<2>(A.w_up, DM, DFF, (bf16*)(ws + WS_WGU), A.ffn_norm_w, scr, r, lane); continue; } r -= I_G;
        p0_transpose_item<0>(A.w_down, DFF, DM, (bf16*)(ws + WS_WD), nullptr, scr, r, lane);
    }
    {
        float* ct = (float*)(ws + WS_ROPE); float* st = ct + SEQ * 32;
        for (int idx = gw * 64 + lane; idx < SEQ * 32; idx += NGW * 64) {
            const int pos = idx >> 5, j = idx & 31;
            const float inv = __builtin_amdgcn_exp2f(-(float)j * (13.287712379549449f / 32.0f));
            const float ang = (float)pos * inv;
            double t = (double)ang * 0.15915494309189535; t -= __builtin_rint(t);
            ct[idx] = __builtin_amdgcn_cosf((float)t); st[idx] = __builtin_amdgcn_sinf((float)t);
        }
    }
    bf16* XN = (bf16*)(ws + WS_XN);
    f32x4 wg[4];
#pragma unroll
    for (int j = 0; j < 4; ++j) wg[j] = ((const f32x4*)A.attn_norm_w)[lane + 64 * j];
    for (int m0 = gw * 8; m0 < TOK; m0 += NGW * 8) {
        f32x4 v[8][4];
#pragma unroll
        for (int u = 0; u < 8; ++u) { const f32x4* xr = (const f32x4*)(A.x + (size_t)(m0 + u) * DM) + lane;
#pragma unroll
            for (int j = 0; j < 4; ++j) v[u][j] = xr[64 * j]; }
#pragma unroll
        for (int u = 0; u < 8; ++u) { float s = 0.f;
#pragma unroll
            for (int j = 0; j < 4; ++j) s += (v[u][j].x * v[u][j].x + v[u][j].y * v[u][j].y) + (v[u][j].z * v[u][j].z + v[u][j].w * v[u][j].w);
            const float rs = 1.f / sqrtf(wave_sum(s) * (1.f / DM) + EPS);
            u32x2* o8 = (u32x2*)(XN + (size_t)(m0 + u) * DM) + lane;
#pragma unroll
            for (int j = 0; j < 4; ++j) { const f32x4 w = wg[j]; u32x2 o; o.x = pk2(v[u][j].x * rs * w.x, v[u][j].y * rs * w.y); o.y = pk2(v[u][j].z * rs * w.z, v[u][j].w * rs * w.w); o8[64 * j] = o; } }
    }
}

__device__ __forceinline__ void stage_rows(LAS unsigned char* st, const f32x16& o0, const f32x16& o1, float scale, int lane) {
    const int r32 = lane & 31, hi = lane >> 5;
#pragma unroll
    for (int g = 0; g < 4; ++g) {
        u32x2 a, c; a.x = pk2(o0[4 * g] * scale, o0[4 * g + 1] * scale); a.y = pk2(o0[4 * g + 2] * scale, o0[4 * g + 3] * scale); c.x = pk2(o1[4 * g] * scale, o1[4 * g + 1] * scale); c.y = pk2(o1[4 * g + 2] * scale, o1[4 * g + 3] * scale);
        *(LAS u32x2*)(st + r32 * 144 + (8 * g + 4 * hi) * 2) = a; *(LAS u32x2*)(st + r32 * 144 + 64 + (8 * g + 4 * hi) * 2) = c;
    }
    asm volatile("s_waitcnt lgkmcnt(0)" ::: "memory");
}
__device__ __forceinline__ u32x4 staged_chunk(LAS const unsigned char* st, int i, int lane) { return *(LAS const u32x4*)(st + (8 * i + (lane >> 3)) * 144 + (lane & 7) * 16); }

constexpr float SB_EXIT_BITS = 40.f;
template <bool MASK>
__device__ __forceinline__ void sb_tile(f32x16& o0, f32x16& o1, float& carry, const bf16x8 (&qr)[4], LAS const unsigned char* Kb, LAS const unsigned char* Vb, const f16x8& U0, const f16x8& U1, const f16x8& ONES,
                                        int kbase, int trow, int r32, int hi) {
    f32x16 p0 = {}, p1 = {};
    { bf16x8 ka[4], kb[4];
#pragma unroll
      for (int d0 = 0; d0 < 4; ++d0) { ka[d0] = *(LAS const bf16x8*)(Kb + d0 * 2048); kb[d0] = *(LAS const bf16x8*)(Kb + d0 * 2048 + 512); }
#pragma unroll
      for (int d0 = 0; d0 < 4; ++d0) { p0 = MFMA_BF16(ka[d0], qr[d0], p0); p1 = MFMA_BF16(kb[d0], qr[d0], p1); } }
    f32x16 s0, s1;
#pragma unroll
    for (int r = 0; r < 16; ++r) {
        const float z0 = __builtin_fminf(p0[r], 126.f), z1 = __builtin_fminf(p1[r], 126.f);
        p0[r] = z0; p1[r] = z1;
        float a = __builtin_amdgcn_logf(1.f + __builtin_amdgcn_exp2f(z0)), b = __builtin_amdgcn_logf(1.f + __builtin_amdgcn_exp2f(z1));
        if (MASK) { const int key = kbase + (r & 3) + 8 * (r >> 2); if (!(key < trow)) a = 0.f; if (!(key + 32 < trow)) b = 0.f; }
        s0[r] = a; s1[r] = b;
    }
    f16x8 h0a, h0b, h1a, h1b;
#pragma unroll
    for (int i = 0; i < 8; ++i) { h0a[i] = (_Float16)s0[i]; h0b[i] = (_Float16)s0[8 + i]; h1a[i] = (_Float16)s1[i]; h1b[i] = (_Float16)s1[8 + i]; }
    f32x16 ci;
#pragma unroll
    for (int r = 0; r < 16; ++r) ci[r] = carry;
    f32x16 c1 = MFMA_F16(U0, h1a, ci); c1 = MFMA_F16(U1, h1b, c1);
    f32x16 c0 = MFMA_F16(ONES, h1a, ci); c0 = MFMA_F16(ONES, h1b, c0); c0 = MFMA_F16(U0, h0a, c0); c0 = MFMA_F16(U1, h0b, c0);
    carry = __shfl(c0[0], r32);
#pragma unroll
    for (int r = 0; r < 16; ++r) {
        float a = __builtin_amdgcn_exp2f(p0[r] - c0[r]), b = __builtin_amdgcn_exp2f(p1[r] - c1[r]);
        if (MASK) { const int key = kbase + (r & 3) + 8 * (r >> 2); if (!(key < trow)) a = 0.f; if (!(key + 32 < trow)) b = 0.f; }
        p0[r] = a; p1[r] = b;
    }
    u32x4 w[4];
#pragma unroll
    for (int i = 0; i < 4; ++i) { w[0][i] = pk2(p0[2 * i], p0[2 * i + 1]); w[1][i] = pk2(p0[8 + 2 * i], p0[8 + 2 * i + 1]); w[2][i] = pk2(p1[2 * i], p1[2 * i + 1]); w[3][i] = pk2(p1[8 + 2 * i], p1[8 + 2 * i + 1]); }
    bf16x8 va[4], vb4[4];
#pragma unroll
    for (int kk = 0; kk < 4; ++kk) {
        const s16x4 lo = vtr(Vb + kk * 1024), hh = vtr(Vb + kk * 1024 + 512), l2 = vtr(Vb + 4096 + kk * 1024), h2 = vtr(Vb + 4096 + kk * 1024 + 512);
        va[kk] = (bf16x8){lo[0], lo[1], lo[2], lo[3], hh[0], hh[1], hh[2], hh[3]}; vb4[kk] = (bf16x8){l2[0], l2[1], l2[2], l2[3], h2[0], h2[1], h2[2], h2[3]};
    }
#pragma unroll
    for (int kk = 0; kk < 4; ++kk) { const bf16x8 pf = __builtin_bit_cast(bf16x8, w[kk]); o0 = MFMA_BF16(va[kk], pf, o0); o1 = MFMA_BF16(vb4[kk], pf, o1); }
}

constexpr int SB_STAGE = 98304, SB_STAT = 135168;
__device__ __forceinline__ void sb_unit(int b, int h, int qb, const bf16* __restrict__ QKV, bf16* __restrict__ MIX, LAS unsigned char* lds) {
    const int tid = threadIdx.x, lane = tid & 63, r32 = lane & 31, hi = lane >> 5;
    const int wid = __builtin_amdgcn_readfirstlane(tid >> 6);
    const size_t rowbase = (size_t)b * SEQ;
    const int q0 = qb * 256, wrow0 = q0 + wid * 32, trow = wrow0 + r32;
    bf16x8 qr[4];
    { const bf16* Qp = head_base(QKV, 3, b, h) + (size_t)trow * HD + hi * 8;
#pragma unroll
      for (int d0 = 0; d0 < 4; ++d0) qr[d0] = *(const bf16x8*)(Qp + d0 * 16); }
    const bf16* Ksrc = head_base(QKV, 4, b, h) + (size_t)lane * HD + wid * 8;
    const bf16* Vsrc = head_base(QKV, 5, b, h) + (size_t)(16 * (wid & 3) + (lane >> 2)) * HD + (wid >> 2) * 32 + (lane & 3) * 8;
    const int stoff = wid * 1024 + lane * 16;
    const int kt0 = 4 * qb - 2;
    const int kbot = kt0 < 0 ? 0 : kt0;
    { u32x4 kr[6], vr[6];
#pragma unroll
      for (int sl = 0; sl < 6; ++sl) if (kt0 + sl >= 0) { kr[sl] = *(const u32x4*)(Ksrc + (size_t)(kt0 + sl) * 64 * HD); vr[sl] = *(const u32x4*)(Vsrc + (size_t)(kt0 + sl) * 64 * HD); }
#pragma unroll
      for (int sl = 0; sl < 6; ++sl) if (kt0 + sl >= 0) { *(LAS u32x4*)(lds + sl * 16384 + stoff) = kr[sl]; *(LAS u32x4*)(lds + sl * 16384 + 8192 + stoff) = vr[sl]; } }
    f16x8 U0, U1, ONES;
#pragma unroll
    for (int i = 0; i < 8; ++i) { const int j = (i & 3) + 8 * (i >> 2) + 4 * hi; U0[i] = (j >= r32) ? (_Float16)1.f : (_Float16)0.f; U1[i] = (j + 16 >= r32) ? (_Float16)1.f : (_Float16)0.f; ONES[i] = (_Float16)1.f; }
    __syncthreads();
    float carry = 0.f; f32x16 o0 = {}, o1 = {}; bool wfin = false;
    const int kfo = hi * 1024 + r32 * 16;
    const int vbo = ((lane >> 4) & 1) * 32 + (lane & 3) * 8 + (4 * hi + ((lane & 15) >> 2)) * 64;
#pragma unroll 1
    for (int kt = (wrow0 + 30) >> 6; kt >= kbot; --kt) {
        const int sl = kt - kt0;
        LAS const unsigned char* Kb = lds + sl * 16384 + kfo; LAS const unsigned char* Vb = lds + sl * 16384 + 8192 + vbo;
        const int kbase = 64 * kt + 4 * hi;
        if (64 * kt + 63 >= wrow0) sb_tile<true>(o0, o1, carry, qr, Kb, Vb, U0, U1, ONES, kbase, trow, r32, hi);
        else sb_tile<false>(o0, o1, carry, qr, Kb, Vb, U0, U1, ONES, kbase, trow, r32, hi);
        if (__all(carry > SB_EXIT_BITS)) { wfin = true; break; }
    }
    if (kbot == 0) wfin = true;
    LAS unsigned* stat = (LAS unsigned*)(lds + SB_STAT);
    if (lane == 0) stat[16 + wid] = wfin ? 1u : 0u;
    __syncthreads();
    bool alldone;
    { const u32x4 sa = *(LAS const u32x4*)(stat + 16), sb4 = *(LAS const u32x4*)(stat + 20); alldone = (sa.x & sa.y & sa.z & sa.w & sb4.x & sb4.y & sb4.z & sb4.w) != 0u; }
    if (!alldone) {
        const int NT = kt0;
        __syncthreads();
        u32x4 kreg = *(const u32x4*)(Ksrc + (size_t)(NT - 1) * 64 * HD), vreg = *(const u32x4*)(Vsrc + (size_t)(NT - 1) * 64 * HD);
        *(LAS u32x4*)(lds + stoff) = kreg; *(LAS u32x4*)(lds + 16384 + stoff) = vreg;
        __syncthreads();
#pragma unroll 1
        for (int it = 0; it < NT; ++it) {
            const int kt = NT - 1 - it, cur = it & 1;
            const bool more = it + 1 < NT;
            if (more) { kreg = *(const u32x4*)(Ksrc + (size_t)(kt - 1) * 64 * HD); vreg = *(const u32x4*)(Vsrc + (size_t)(kt - 1) * 64 * HD); }
            if (!wfin) {
                LAS const unsigned char* Kb = lds + cur * 8192 + kfo; LAS const unsigned char* Vb = lds + 16384 + cur * 8192 + vbo;
                sb_tile<false>(o0, o1, carry, qr, Kb, Vb, U0, U1, ONES, 64 * kt + 4 * hi, trow, r32, hi);
            }
            if (more) { *(LAS u32x4*)(lds + (cur ^ 1) * 8192 + stoff) = kreg; *(LAS u32x4*)(lds + 16384 + (cur ^ 1) * 8192 + stoff) = vreg; }
            wfin = __all(carry > SB_EXIT_BITS) != 0;
            if (lane == 0) stat[cur * 8 + wid] = wfin ? 1u : 0u;
            __syncthreads();
            const u32x4 sa = *(LAS const u32x4*)(stat + cur * 8), sb4 = *(LAS const u32x4*)(stat + cur * 8 + 4);
            if ((sa.x & sa.y & sa.z & sa.w & sb4.x & sb4.y & sb4.z & sb4.w) != 0u) break;
        }
    }
    { LAS unsigned char* st = lds + SB_STAGE + wid * 4608;
      stage_rows(st, o0, o1, 1.f, lane);
      bf16* Op = MIX + (rowbase + wrow0) * DM + 512 + h * 64 + (lane & 7) * 8;
#pragma unroll
      for (int i = 0; i < 4; ++i) *(u32x4*)(Op + (size_t)(8 * i + (lane >> 3)) * DM) = staged_chunk(st, i, lane);
      asm volatile("s_waitcnt lgkmcnt(0)" ::: "memory"); }
    __syncthreads();
}

struct DilCtx { const bf16* kbase; int lr, c, pb, r32, hi, lane, c8, vst, vbo, kst, kfo; };
constexpr int DIL_KOFF = 4096, DIL_KPITCH = 528, DIL_WL = 8704;
__device__ __forceinline__ void dil_load_group(const DilCtx& X, int G, u32x4 (&kr)[4], u32x4 (&vr)[4]) {
    const int pos0 = 32 * (X.pb - 4 + G);
#pragma unroll
    for (int j = 0; j < 4; ++j) { const bf16* rowp = X.kbase + (size_t)(((pos0 + 8 * j + (X.lane >> 3)) << X.lr) + X.c) * HD + X.c8 * 8;
        kr[j] = *(const u32x4*)rowp; vr[j] = *(const u32x4*)(rowp + SLAB); }
}
template <bool fixed>
__device__ __forceinline__ void dil_step(const DilCtx& X, int G, u32x4 (&kr)[4], u32x4 (&vr)[4], const bf16x8 (&qr)[2][4], f32x16 (&o0)[2], f32x16 (&o1)[2], float (&mrun)[2], float (&lrun)[2], LAS unsigned char* wl) {
    const int r32 = X.r32, hi = X.hi;
#pragma unroll
    for (int j = 0; j < 4; ++j) { *(LAS u32x4*)(wl + X.vst + j * 512) = vr[j]; *(LAS u32x4*)(wl + X.kst + j * 128) = kr[j]; }
    if (G + 1 < 6) dil_load_group(X, G + 1, kr, vr);
    asm volatile("s_waitcnt lgkmcnt(0)" ::: "memory");
    bf16x8 kf[4];
#pragma unroll
    for (int d0 = 0; d0 < 4; ++d0) kf[d0] = *(LAS const bf16x8*)(wl + X.kfo + d0 * (2 * DIL_KPITCH));
#pragma unroll
    for (int u = 0; u < 2; ++u) {
        const int g = G - u;
        if (g >= 0 && g <= 4) {
            f32x16 pp = {};
#pragma unroll
            for (int d0 = 0; d0 < 4; ++d0) pp = MFMA_BF16(kf[d0], qr[u][d0], pp);
            if (g == 0) {
#pragma unroll
                for (int r = 0; r < 16; ++r) if (crow(r, hi) < r32) pp[r] = -INFINITY;
            } else if (g == 4) {
#pragma unroll
                for (int r = 0; r < 16; ++r) if (crow(r, hi) > r32) pp[r] = -INFINITY;
            }
            if (fixed) {
                float ls = 0.f;
#pragma unroll
                for (int r = 0; r < 16; ++r) { pp[r] = __builtin_amdgcn_exp2f(pp[r]); ls += pp[r]; }
                lrun[u] += ls;
            } else {
                float mx = pp[0];
#pragma unroll
                for (int r = 1; r < 16; ++r) mx = __builtin_fmaxf(mx, pp[r]);
                mx = __builtin_fmaxf(mx, __shfl_xor(mx, 32));
                const float mnew = __builtin_fmaxf(mrun[u], mx);
                const float alpha = __builtin_amdgcn_exp2f(mrun[u] - mnew);
                mrun[u] = mnew;
                float ls = 0.f;
#pragma unroll
                for (int r = 0; r < 16; ++r) { pp[r] = __builtin_amdgcn_exp2f(pp[r] - mnew); ls += pp[r]; }
                lrun[u] = lrun[u] * alpha + ls;
#pragma unroll
                for (int r = 0; r < 16; ++r) { o0[u][r] *= alpha; o1[u][r] *= alpha; }
            }
            u32x4 w[2];
#pragma unroll
            for (int i = 0; i < 4; ++i) { w[0][i] = pk2(pp[2 * i], pp[2 * i + 1]); w[1][i] = pk2(pp[8 + 2 * i], pp[8 + 2 * i + 1]); }
            LAS const unsigned char* vb = wl + X.vbo;
            bf16x8 va[2], vc[2];
#pragma unroll
            for (int kk = 0; kk < 2; ++kk) {
                const s16x4 lo = vtr(vb + kk * 1024), hh = vtr(vb + kk * 1024 + 512), l2 = vtr(vb + 2048 + kk * 1024), h2 = vtr(vb + 2048 + kk * 1024 + 512);
                va[kk] = (bf16x8){lo[0], lo[1], lo[2], lo[3], hh[0], hh[1], hh[2], hh[3]}; vc[kk] = (bf16x8){l2[0], l2[1], l2[2], l2[3], h2[0], h2[1], h2[2], h2[3]};
            }
#pragma unroll
            for (int kk = 0; kk < 2; ++kk) { const bf16x8 pf = __builtin_bit_cast(bf16x8, w[kk]); o0[u] = MFMA_BF16(va[kk], pf, o0[u]); o1[u] = MFMA_BF16(vc[kk], pf, o1[u]); }
        }
    }
    asm volatile("s_waitcnt lgkmcnt(0)" ::: "memory");
}
template <bool fixed>
__device__ __forceinline__ void dil_pair(int pairid, const bf16* __restrict__ QKV, bf16* __restrict__ DILO, float* __restrict__ LSE, LAS unsigned char* wl, int lane) {
    const int r32 = lane & 31, hi = lane >> 5;
    const int task = 2 * pairid;
    const int bh = task / 384, rem = task - bh * 384, idx = rem & 127, br = rem >> 7, h = bh & 7;
    const size_t rowbase = (size_t)(bh >> 3) * SEQ, hb = (size_t)bh * (SEQ * HD);
    const int lr = 2 * br;
    const int nbs = 128 >> lr;
    const int c = idx / nbs, pb = idx - c * nbs;
    bf16x8 qr[2][4];
#pragma unroll
    for (int u = 0; u < 2; ++u) {
        const int tq0 = (((32 * (pb + u) + r32) << lr) + c);
        const bf16* Qp = QKV + hb + (size_t)tq0 * HD + hi * 8;
#pragma unroll
        for (int d0 = 0; d0 < 4; ++d0) qr[u][d0] = *(const bf16x8*)(Qp + d0 * 16);
    }
    const int G_lo = (pb < 4) ? (4 - pb) : 0;
    DilCtx X; X.kbase = QKV + SLAB + hb; X.lr = lr; X.c = c; X.pb = pb; X.r32 = r32; X.hi = hi; X.lane = lane; X.c8 = lane & 7;
    X.vst = ((lane & 7) >> 2) * 2048 + (lane >> 3) * 64 + (lane & 3) * 16; X.vbo = ((lane >> 4) & 1) * 32 + (lane & 3) * 8 + (4 * hi + ((lane & 15) >> 2)) * 64;
    X.kst = DIL_KOFF + (lane & 7) * DIL_KPITCH + (lane >> 3) * 16;
    X.kfo = DIL_KOFF + hi * DIL_KPITCH + r32 * 16;
    const float m0 = fixed ? 0.f : -1e30f;
    float mrun[2] = {m0, m0}, lrun[2] = {0.f, 0.f}; f32x16 o0[2] = {}, o1[2] = {};
    u32x4 kr[4], vr[4];
    dil_load_group(X, G_lo, kr, vr);
#pragma unroll 1
    for (int G = G_lo; G < 6; ++G) dil_step<fixed>(X, G, kr, vr, qr, o0, o1, mrun, lrun, wl);
#pragma unroll
    for (int u = 0; u < 2; ++u) {
        const float lt = lrun[u] + __shfl_xor(lrun[u], 32);
        const float inv = __builtin_amdgcn_rcpf(lt);
        const int tqu = (((32 * (pb + u) + r32) << lr) + c);
        stage_rows(wl, o0[u], o1[u], inv, lane);
#pragma unroll
        for (int i = 0; i < 4; ++i) { const int tr = (((32 * (pb + u) + 8 * i + (lane >> 3)) << lr) + c);
            *(u32x4*)(DILO + ((size_t)br * TOK + rowbase + tr) * 512 + h * 64 + (lane & 7) * 8) = staged_chunk(wl, i, lane); }
        asm volatile("s_waitcnt lgkmcnt(0)" ::: "memory");
        if (hi == 0) LSE[((size_t)br * TOK + rowbase + tqu) * 8 + h] = mrun[u] + __builtin_amdgcn_logf(lt);
    }
}

__device__ __forceinline__ void p2c_merge_norm(const Args& A, int vcu, int G, int wave, int lane) {
    const int gw = vcu * NWAVES + wave, NGW = G * NWAVES;
    const bf16* DILO = (const bf16*)(A.ws + WS_DILO); const float* LSE = (const float*)(A.ws + WS_LSE); const bf16* MIX = (const bf16*)(A.ws + WS_MIX); bf16* MIXN = (bf16*)(A.ws + WS_MIXN);
    float wd[8], wsb[8];
#pragma unroll
    for (int i = 0; i < 8; ++i) { wd[i] = A.dil_norm_w[8 * lane + i]; wsb[i] = A.sb_norm_w[8 * lane + i]; }
    for (int m0 = gw * 8; m0 < TOK; m0 += NGW * 8) {
        u32x4 d[8][3], sv[8]; float ls[8][3];
#pragma unroll
        for (int u = 0; u < 8; ++u) { const size_t m = (size_t)(m0 + u);
#pragma unroll
            for (int br = 0; br < 3; ++br) { d[u][br] = *(const u32x4*)(DILO + ((size_t)br * TOK + m) * 512 + 8 * lane); ls[u][br] = LSE[((size_t)br * TOK + m) * 8 + (lane >> 3)]; }
            sv[u] = *(const u32x4*)(MIX + m * DM + 512 + 8 * lane); }
#pragma unroll
        for (int u = 0; u < 8; ++u) {
            const float mx = __builtin_fmaxf(ls[u][0], __builtin_fmaxf(ls[u][1], ls[u][2]));
            float w0 = __builtin_amdgcn_exp2f(ls[u][0] - mx), w1 = __builtin_amdgcn_exp2f(ls[u][1] - mx), w2 = __builtin_amdgcn_exp2f(ls[u][2] - mx);
            const float inv = 1.f / (w0 + w1 + w2); w0 *= inv; w1 *= inv; w2 *= inv;
            float v[8], x[8]; float sd = 0.f, sb = 0.f;
#pragma unroll
            for (int i = 0; i < 4; ++i) {
                v[2 * i] = w0 * bf_lo(d[u][0][i]) + w1 * bf_lo(d[u][1][i]) + w2 * bf_lo(d[u][2][i]); v[2 * i + 1] = w0 * bf_hi(d[u][0][i]) + w1 * bf_hi(d[u][1][i]) + w2 * bf_hi(d[u][2][i]);
                x[2 * i] = bf_lo(sv[u][i]); x[2 * i + 1] = bf_hi(sv[u][i]); }
#pragma unroll
            for (int i = 0; i < 8; ++i) { sd += v[i] * v[i]; sb += x[i] * x[i]; }
            const float rd = 1.f / sqrtf(wave_sum(sd) * (1.f / 512.f) + EPS), rb = 1.f / sqrtf(wave_sum(sb) * (1.f / 512.f) + EPS);
            u32x4 oa, ob;
#pragma unroll
            for (int i = 0; i < 4; ++i) { oa[i] = pk2(v[2 * i] * rd * wd[2 * i], v[2 * i + 1] * rd * wd[2 * i + 1]); ob[i] = pk2(x[2 * i] * rb * wsb[2 * i], x[2 * i + 1] * rb * wsb[2 * i + 1]); }
            bf16* q = MIXN + (size_t)(m0 + u) * DM + 8 * lane;
            *(u32x4*)q = oa; *(u32x4*)(q + 512) = ob;
        }
    }
}

#ifndef REP_P1
#define REP_P1 1
#endif
#ifndef REP_SB
#define REP_SB 1
#endif
#ifndef REP_DIL
#define REP_DIL 1
#endif
#ifndef REP_P0
#define REP_P0 1
#endif
#ifndef REP_P2C
#define REP_P2C 1
#endif
#ifndef REP_P3
#define REP_P3 1
#endif
#ifndef REP_P5
#define REP_P5 1
#endif
#ifndef REP_P4
#define REP_P4 1
#endif
__global__ void __launch_bounds__(NWAVES * 64, 2) hymba_fwd(Args args) {
    extern __shared__ __attribute__((aligned(16))) unsigned char lds_raw[];
    cg::grid_group grid = cg::this_grid();
    LAS unsigned char* lds = (LAS unsigned char*)lds_raw;
    const int tid = threadIdx.x, lane = tid & 63, wave = __builtin_amdgcn_readfirstlane(tid >> 6);
    const int G = gridDim.x; const int bx = blockIdx.x; const int vcu = (G % 8 == 0) ? (bx % 8) * (G / 8) + bx / 8 : bx;
    unsigned char* ws = args.ws;
    const int lo = args.ph_lo, hi = args.ph_hi;
#define IN(k) (lo <= (k) && (k) < hi)
#define SEAM(k) do { if (IN(k)) { if (hi > 1000) grid.sync(); else xcd_barrier(bar); } } while (0)
    if (tid < 64) ((LAS unsigned*)(lds + LDS_BYTES - 256))[tid] = 0u;
    __syncthreads();
    XcdBarrier bar = xcd_barrier_post((unsigned*)(ws + WS_CTL) + 4096, (volatile LAS unsigned*)(lds + LDS_BYTES - 256) + 8);

    if (IN(0)) { for (int rep = 0; rep < REP_P0; ++rep) p0_prologue(args, lds, vcu, G, wave, lane); }
    SEAM(0);
    if (IN(1)) {
#define P1_BODY { pg8::Gemm g{(const pg8::bf16_t*)(ws + WS_XN), (const pg8::bf16_t*)(ws + WS_WIN), TOK, DIN, DM}; pg8::StaticOrder S; S.init(TOK, DIN, G, bx); \
        pg8::EpiQKV E{(pg8::bf16_t*)(ws + WS_QKV), DIN, 2, 4, C_QS / 256, C_QS / 256 + 1, QSCALE, args.q_norm_w, args.k_norm_w, (const float*)(ws + WS_ROPE), (const float*)(ws + WS_ROPE) + SEQ * 32, EPS}; \
        pg8::gemm_phase<pg8::EpiQKV, pg8::StaticOrder, true, true>(lds, g, S, E); }
        P1_BODY
#if REP_P1 == 2
        asm volatile("" ::: "memory");
        P1_BODY
#endif
#undef P1_BODY
    }
    SEAM(1);
    if (IN(3)) {
        const bf16* QKV = (const bf16*)(ws + WS_QKV);
        for (int rep = 0; rep < REP_SB; ++rep)
        for (int v = vcu; v < 256; v += G) {
            const int s = v & 3, bh = v >> 2;
#pragma unroll 1
            for (int i = 0; i < 4; ++i) { const int qb = (i == 0) ? s : (i == 1) ? 7 - s : (i == 2) ? 8 + s : 15 - s; sb_unit(bh >> 3, bh & 7, qb, QKV, (bf16*)(ws + WS_MIX), lds); }
        }
        __syncthreads();
        bool dil_fixed;
        {
            float mq = __builtin_fabsf(args.q_norm_w[lane]), mk = __builtin_fabsf(args.k_norm_w[lane]);
#pragma unroll
            for (int o = 1; o < 64; o <<= 1) { mq = __builtin_fmaxf(mq, __shfl_xor(mq, o)); mk = __builtin_fmaxf(mk, __shfl_xor(mk, o)); }
            dil_fixed = (8.f * 1.4426950408889634f * 1.02f) * mq * mk < 100.f;
        }
        LAS unsigned char* wl = lds + 32768 + wave * DIL_WL;
#define RUN_DIL(FX) do { for (int rep = 0; rep < REP_DIL; ++rep) { const int NW = G * NWAVES, gw = vcu * NWAVES + wave; \
            _Pragma("unroll 1") for (int t = gw; t < 64 * 384 / 2; t += NW) { int pr = t;     \
                if (G == 256) { const int x = gw >> 8, lw = gw & 255, k = t / NW; pr = x * 1536 + ((lw + 37 * k) & 255) + 256 * k; }     \
                dil_pair<FX>(pr, QKV, (bf16*)(ws + WS_DILO), (float*)(ws + WS_LSE), wl, lane); } } } while (0)
        if (dil_fixed) RUN_DIL(true); else RUN_DIL(false);
#undef RUN_DIL
    }
    SEAM(3);
    if (IN(4)) { for (int rep = 0; rep < REP_P2C; ++rep) p2c_merge_norm(args, vcu, G, wave, lane); }
    SEAM(4);
    if (IN(5)) {
        for (int rep = 0; rep < REP_P3; ++rep) {
        pg8::Gemm g{(const pg8::bf16_t*)(ws + WS_MIXN), (const pg8::bf16_t*)(ws + WS_WOUT), TOK, DM, DM}; pg8::StaticOrder S; S.init(TOK, DM, G, bx);
        pg8::EpiRes1 E{args.x, (pg8::bf16_t*)(ws + WS_XN), (float*)(ws + WS_SSQ), DM};
        pg8::gemm_phase<pg8::EpiRes1, pg8::StaticOrder, true, true>(lds, g, S, E);
        }
    }
    SEAM(5);
    if (IN(6)) {
        for (int rep = 0; rep < REP_P4; ++rep) {
        pg8::Gemm g{(const pg8::bf16_t*)(ws + WS_XN), (const pg8::bf16_t*)(ws + WS_WGU), TOK, 2 * DFF, DM}; pg8::StaticOrder S; S.init(TOK, 2 * DFF, G, bx);
        pg8::EpiSwiGLU E{(pg8::bf16_t*)(ws + WS_ACT), DFF, (const float*)(ws + WS_SSQ), 1.f / DM, EPS};
        pg8::gemm_phase<pg8::EpiSwiGLU, pg8::StaticOrder, true, true>(lds, g, S, E);
        }
    }
    SEAM(6);
    if (IN(7)) {
        for (int rep = REP_P5 - 1; rep >= 0; --rep) {
        pg8::Gemm g{(const pg8::bf16_t*)(ws + WS_ACT), (const pg8::bf16_t*)(ws + WS_WD), TOK, DM, DFF}; pg8::StaticOrder S; S.init(TOK, DM, G, bx);
        pg8::EpiRes2 E{(const pg8::bf16_t*)(ws + WS_XN), rep ? (float*)(ws + WS_MIX) : args.out, DM};
        pg8::gemm_phase<pg8::EpiRes2, pg8::StaticOrder, true, true>(lds, g, S, E);
        }
    }
#undef IN
#undef SEAM
}

extern "C" void kernel_launch(void* const* d_in, const int* in_sizes, int n_in, void* d_out, int out_size, void* d_ws, size_t ws_size, hipStream_t stream) {
    static int grid = 0;
    if (grid == 0) {
        if (n_in != 12 || in_sizes[0] != TOK * DM || out_size != TOK * DM || ws_size < WS_END) { fprintf(stderr, "kernel_launch: unexpected shapes / workspace (n_in %d, in0 %d, out %d, ws %zu)\n", n_in, n_in > 0 ? in_sizes[0] : -1, out_size, ws_size); grid = -1; return; }
        int dev = 0, cus = 0, per_cu = 0;
        if (hipGetDevice(&dev) != hipSuccess || hipDeviceGetAttribute(&cus, hipDeviceAttributeMultiprocessorCount, dev) != hipSuccess) { grid = -1; return; }
        if (hipFuncSetAttribute((const void*)hymba_fwd, hipFuncAttributeMaxDynamicSharedMemorySize, LDS_BYTES) != hipSuccess) { fprintf(stderr, "kernel_launch: hipFuncSetAttribute failed\n"); grid = -1; return; }
        if (hipOccupancyMaxActiveBlocksPerMultiprocessor(&per_cu, (const void*)hymba_fwd, NWAVES * 64, LDS_BYTES) != hipSuccess || per_cu < 1) { fprintf(stderr, "kernel_launch: occupancy query says %d blocks per CU\n", per_cu); per_cu = 1; }
        (void)hipGetLastError();
        grid = cus;
    }
    if (grid < 0) return;
    if (hipMemsetAsync((char*)d_ws + WS_CTL, 0, 65536, stream) != hipSuccess) { fprintf(stderr, "kernel_launch: hipMemsetAsync failed\n"); return; }
    Args a{};
    a.x = (const float*)d_in[0]; a.attn_norm_w = (const float*)d_in[1]; a.w_in = (const float*)d_in[2]; a.q_norm_w = (const float*)d_in[3]; a.k_norm_w = (const float*)d_in[4];
    a.dil_norm_w = (const float*)d_in[5]; a.sb_norm_w = (const float*)d_in[6]; a.w_out = (const float*)d_in[7]; a.ffn_norm_w = (const float*)d_in[8];
    a.w_gate = (const float*)d_in[9]; a.w_up = (const float*)d_in[10]; a.w_down = (const float*)d_in[11];
    a.out = (float*)d_out; a.ws = (unsigned char*)d_ws; a.ph_lo = 0; a.ph_hi = 8;
    void* kargs[] = {&a};
    const hipError_t le = hipLaunchCooperativeKernel((const void*)hymba_fwd, dim3(grid), dim3(NWAVES * 64), kargs, LDS_BYTES, stream);
    if (le != hipSuccess) fprintf(stderr, "kernel_launch: cooperative launch failed: %s (grid %d)\n", hipGetErrorName(le), grid);
}
```

```cpp
#include <hip/hip_runtime.h>
#include <hip/hip_cooperative_groups.h>
#include <cstdio>
#include <cstdint>
#include <cmath>
namespace cg = cooperative_groups;
namespace pg8 {
#define PG8_LAS __attribute__((address_space(3)))
typedef unsigned short bf16_t;
typedef short bf16x8 __attribute__((ext_vector_type(8)));
typedef float f32x4 __attribute__((ext_vector_type(4)));
typedef unsigned u32x4 __attribute__((ext_vector_type(4)));
constexpr int BM = 256, BK = 64, HALF = 128, HTB = HALF * BK * 2  , STAGE_BYTES = 8 * HTB, NXCD = 8, WGM = 2  ;

__host__ __device__ __forceinline__ int lds_byte(int r, int c) { const int st = (r >> 4) * 2 + (c >> 5), rr = r & 15, cc = c & 31, ob = rr * 64 + cc * 2; return st * 1024 + (ob ^ (((ob >> 9) & 1) << 5)); }
__host__ __device__ __forceinline__ void stage_rc(int b, int& R, int& C) { const int st = b / 1024, sb = b % 1024, swz = sb ^ (((sb >> 9) & 1) << 5); R = (st >> 1) * 16 + swz / 64; C = (st & 1) * 32 + (swz % 64) / 2; }
__host__ __device__ __forceinline__ int perm32(int rho) { const int n = rho >> 4, i = rho & 15; return 8 * (i >> 2) + 4 * n + (i & 3); }

struct Unit { int pm, pn; };
struct Gemm { const bf16_t* A; const bf16_t* Bt; int M, N, K; };

struct StaticOrder {
    int nM, nN, nwg, G, c;
    __host__ __device__ void init(int M, int N, int G_, int c_) { nM = M / BM; nN = N / BM; nwg = nM * nN; G = G_; c = c_; }
    __host__ __device__ bool next(int i, Unit& u) const {
        const long L = (long)i * G + c; if (L >= nwg) return false;
        int wgid = (int)L; { const int q = nwg / NXCD, r = nwg % NXCD, xcd = wgid % NXCD, off = wgid / NXCD; wgid = (xcd < r ? xcd * (q + 1) : r * (q + 1) + (xcd - r) * q) + off; }
        const int nig = WGM * nN, gid = wgid / nig, fm = gid * WGM, gsz = (nM - fm) < WGM ? (nM - fm) : WGM;
        u.pm = fm + ((wgid % nig) % gsz); u.pn = (wgid % nig) / gsz; return true;
    }
    __device__ __forceinline__ void a_ready(const Unit&) const {}
    __device__ __forceinline__ void done(const Unit&) const {}
};

__device__ __forceinline__ unsigned cvt_pk_bf16(float lo, float hi) { unsigned r; asm volatile("v_cvt_pk_bf16_f32 %0, %1, %2" : "=v"(r) : "v"(lo), "v"(hi)); return r; }
typedef float f32x2 __attribute__((ext_vector_type(2)));
struct EpiQKV {
    static constexpr bool PERM = true, AFTER_DRAIN = false;
    static constexpr int M_TOK = 32768;
    bf16_t* O; int ldc; int n_q, n_norm, qs_lo, qs_hi; float scale; const float* qw; const float* kw; const float* ct; const float* st; float eps;
    __device__ __forceinline__ void operator()(const f32x4 (&acc)[2][2][4][2], const Unit& u, int wr, int wc, int fr, int fq) const {
        const int row0 = u.pm * BM + wr * 64 + fr; bf16_t* const Oh = O + (size_t)(u.pn >> 1) * ((size_t)M_TOK * 512) + (size_t)(4 * (u.pn & 1) + wc) * (4096 * 64) + 8 * fq;
        if (u.pn < n_norm) {
            const bool isq = u.pn < n_q; const float* w = isq ? qw : kw; const float osc = isq ? scale : 1.f;
            const f32x4 wl0 = *(const f32x4*)(w + 8 * fq), wl1 = *(const f32x4*)(w + 8 * fq + 4), wh0 = *(const f32x4*)(w + 32 + 8 * fq), wh1 = *(const f32x4*)(w + 32 + 8 * fq + 4);
#pragma unroll
            for (int ab = 0; ab < 4; ++ab) { const int ai = ab >> 1, mb = (ab & 1) * 2;
                f32x4 tc0[4], tc1[4], ts0[4], ts1[4];
#pragma unroll
                for (int m = mb; m < mb + 2; ++m) { const int pos = (row0 + ai * HALF + m * 16) & 4095;
                    tc0[m] = *(const f32x4*)(ct + pos * 32 + 8 * fq); tc1[m] = *(const f32x4*)(ct + pos * 32 + 8 * fq + 4); ts0[m] = *(const f32x4*)(st + pos * 32 + 8 * fq); ts1[m] = *(const f32x4*)(st + pos * 32 + 8 * fq + 4); }
#pragma unroll
                for (int m = mb; m < mb + 2; ++m) { const int r = row0 + ai * HALF + m * 16; const int pos = r & 4095;
                    const f32x4 c0 = tc0[m], c1 = tc1[m], s0 = ts0[m], s1 = ts1[m];
                    const f32x4 a0 = acc[ai][0][m][0], a1 = acc[ai][0][m][1], b0 = acc[ai][1][m][0], b1 = acc[ai][1][m][1];
                    const f32x4 q2 = (a0 * a0 + a1 * a1) + (b0 * b0 + b1 * b1); float ss = (q2[0] + q2[1]) + (q2[2] + q2[3]);
                    ss += __shfl_xor(ss, 16); ss += __shfl_xor(ss, 32);
                    const float rs = __builtin_amdgcn_rsqf(ss * (1.f / 64.f) + eps) * osc;
                    const f32x4 yl0 = a0 * rs * wl0, yl1 = a1 * rs * wl1, yh0 = b0 * rs * wh0, yh1 = b1 * rs * wh1;
                    const f32x4 ol0 = yl0 * c0 - yh0 * s0, ol1 = yl1 * c1 - yh1 * s1, oh0 = yh0 * c0 + yl0 * s0, oh1 = yh1 * c1 + yl1 * s1;
                    bf16_t* rowp = Oh + ((size_t)(r >> 12) * (8 * 4096) + (size_t)pos) * 64;
                    u32x4 wv; wv.x = cvt_pk_bf16(ol0[0], ol0[1]); wv.y = cvt_pk_bf16(ol0[2], ol0[3]); wv.z = cvt_pk_bf16(ol1[0], ol1[1]); wv.w = cvt_pk_bf16(ol1[2], ol1[3]); *(u32x4*)rowp = wv;
                    wv.x = cvt_pk_bf16(oh0[0], oh0[1]); wv.y = cvt_pk_bf16(oh0[2], oh0[3]); wv.z = cvt_pk_bf16(oh1[0], oh1[1]); wv.w = cvt_pk_bf16(oh1[2], oh1[3]); *(u32x4*)(rowp + 32) = wv; }
            }
        } else {
            const float sc = (u.pn >= qs_lo && u.pn <= qs_hi) ? scale : 1.f;
#pragma unroll
            for (int ai = 0; ai < 2; ++ai)
#pragma unroll
                for (int m = 0; m < 4; ++m) { const int r = row0 + ai * HALF + m * 16; bf16_t* rowp = Oh + ((size_t)(r >> 12) * (8 * 4096) + (size_t)(r & 4095)) * 64;
#pragma unroll
                    for (int bj = 0; bj < 2; ++bj) { const f32x4 v0 = acc[ai][bj][m][0] * sc, v1 = acc[ai][bj][m][1] * sc;
                        u32x4 w; w.x = cvt_pk_bf16(v0[0], v0[1]); w.y = cvt_pk_bf16(v0[2], v0[3]); w.z = cvt_pk_bf16(v1[0], v1[1]); w.w = cvt_pk_bf16(v1[2], v1[3]);
                        *(u32x4*)(rowp + bj * 32) = w; } }
        }
    }
};
struct EpiRes1 {
    static constexpr bool PERM = true, AFTER_DRAIN = false;
    const float* base; bf16_t* xn; float* ssq; int ldc;
    __device__ __forceinline__ void operator()(const f32x4 (&acc)[2][2][4][2], const Unit& u, int wr, int wc, int fr, int fq) const {
        const int col0 = u.pn * BM + wc * 32 + 8 * fq;
#pragma unroll
        for (int ab = 0; ab < 4; ++ab) { const int ai = ab >> 1, mb = (ab & 1) * 2;
            f32x4 bx[4][2][2];
#pragma unroll
            for (int m = mb; m < mb + 2; ++m) { const size_t off = (size_t)(u.pm * BM + ai * HALF + wr * 64 + m * 16 + fr) * ldc + col0;
#pragma unroll
                for (int bj = 0; bj < 2; ++bj) { bx[m][bj][0] = __builtin_nontemporal_load((const f32x4*)(base + off + bj * HALF)); bx[m][bj][1] = __builtin_nontemporal_load((const f32x4*)(base + off + bj * HALF + 4)); } }
#pragma unroll
            for (int m = mb; m < mb + 2; ++m) { const int r = u.pm * BM + ai * HALF + wr * 64 + m * 16 + fr; const size_t off = (size_t)r * ldc + col0; float ss = 0.f;
#pragma unroll
                for (int bj = 0; bj < 2; ++bj) { const f32x4 v0 = bx[m][bj][0] + acc[ai][bj][m][0], v1 = bx[m][bj][1] + acc[ai][bj][m][1];
                    u32x4 w; w.x = cvt_pk_bf16(v0[0], v0[1]); w.y = cvt_pk_bf16(v0[2], v0[3]); w.z = cvt_pk_bf16(v1[0], v1[1]); w.w = cvt_pk_bf16(v1[2], v1[3]); *(u32x4*)(xn + off + bj * HALF) = w;
                    ss += ((v0[0] * v0[0] + v0[1] * v0[1]) + (v0[2] * v0[2] + v0[3] * v0[3])) + ((v1[0] * v1[0] + v1[1] * v1[1]) + (v1[2] * v1[2] + v1[3] * v1[3])); }
                ss += __shfl_xor(ss, 16); ss += __shfl_xor(ss, 32);
                if (fq == 0) ssq[(size_t)r * 16 + u.pn * 4 + wc] = ss; }
        }
    }
};
struct EpiSwiGLU {
    static constexpr bool PERM = true, AFTER_DRAIN = false;
    bf16_t* O; int ldc; const float* ssq; float inv_d, eps;
    __device__ __forceinline__ void operator()(const f32x4 (&acc)[2][2][4][2], const Unit& u, int wr, int wc, int fr, int fq) const {
        const int row0 = u.pm * BM + wr * 64 + fr, col0 = u.pn * HALF + wc * 32 + 8 * fq;
        f32x4 sq[2][4];
#pragma unroll
        for (int ai = 0; ai < 2; ++ai)
#pragma unroll
            for (int m = 0; m < 4; ++m) sq[ai][m] = *(const f32x4*)(ssq + (size_t)(row0 + ai * HALF + m * 16) * 16 + 4 * fq);
#pragma unroll
        for (int ai = 0; ai < 2; ++ai)
#pragma unroll
            for (int m = 0; m < 4; ++m) { const int r = row0 + ai * HALF + m * 16;
                float t = (sq[ai][m][0] + sq[ai][m][1]) + (sq[ai][m][2] + sq[ai][m][3]); t += __shfl_xor(t, 16); t += __shfl_xor(t, 32);
                const float rs = __builtin_amdgcn_rsqf(t * inv_d + eps);
                float a[8];
#pragma unroll
                for (int n = 0; n < 2; ++n)
#pragma unroll
                    for (int i = 0; i < 4; ++i) { const float g = acc[ai][0][m][n][i] * rs, uu = acc[ai][1][m][n][i] * rs;
                        a[n * 4 + i] = g * __builtin_amdgcn_rcpf(1.f + __builtin_amdgcn_exp2f(-1.4426950408889634f * g)) * uu; }
                u32x4 w; w.x = cvt_pk_bf16(a[0], a[1]); w.y = cvt_pk_bf16(a[2], a[3]); w.z = cvt_pk_bf16(a[4], a[5]); w.w = cvt_pk_bf16(a[6], a[7]);
                *(u32x4*)(O + (size_t)r * ldc + col0) = w; }
    }
};
struct EpiRes2 {
    static constexpr bool PERM = true, AFTER_DRAIN = false;
    const bf16_t* xn; float* out; int ldc;
    __device__ __forceinline__ void operator()(const f32x4 (&acc)[2][2][4][2], const Unit& u, int wr, int wc, int fr, int fq) const {
        const int col0 = u.pn * BM + wc * 32 + 8 * fq;
#pragma unroll
        for (int ai = 0; ai < 2; ++ai) {
            u32x4 xv[4][2];
#pragma unroll
            for (int m = 0; m < 4; ++m) { const size_t off = (size_t)(u.pm * BM + ai * HALF + wr * 64 + m * 16 + fr) * ldc + col0;
                xv[m][0] = *(const u32x4*)(xn + off); xv[m][1] = *(const u32x4*)(xn + off + HALF); }
#pragma unroll
            for (int m = 0; m < 4; ++m) { const size_t off = (size_t)(u.pm * BM + ai * HALF + wr * 64 + m * 16 + fr) * ldc + col0;
#pragma unroll
                for (int bj = 0; bj < 2; ++bj) { const u32x4 w = xv[m][bj];
                    f32x4 b0, b1; b0[0] = __builtin_bit_cast(float, w.x << 16); b0[1] = __builtin_bit_cast(float, w.x & 0xffff0000u); b0[2] = __builtin_bit_cast(float, w.y << 16); b0[3] = __builtin_bit_cast(float, w.y & 0xffff0000u);
                    b1[0] = __builtin_bit_cast(float, w.z << 16); b1[1] = __builtin_bit_cast(float, w.z & 0xffff0000u); b1[2] = __builtin_bit_cast(float, w.w << 16); b1[3] = __builtin_bit_cast(float, w.w & 0xffff0000u);
                    *(f32x4*)(out + off + bj * HALF) = b0 + acc[ai][bj][m][0]; *(f32x4*)(out + off + bj * HALF + 4) = b1 + acc[ai][bj][m][1]; } }
        }
    }
};
template <class Epi, class Sched, bool ALIGN_EPI = false, bool SP2 = false>
__device__ __forceinline__ void gemm_phase(PG8_LAS unsigned char* lds, const Gemm g, const Sched& S, const Epi& E) {
    const int tid = threadIdx.x, wid = __builtin_amdgcn_readfirstlane(tid >> 6), lane = tid & 63, wr = wid >> 2, wc = wid & 3, fr = lane & 15, fq = lane >> 4;
    const int K = g.K, nt = K / BK;
    unsigned voffA[2], voffB[2];
#pragma unroll
    for (int i = 0; i < 2; ++i) { int R, C; stage_rc(tid * 16 + i * 8192, R, C); const int Rb = Epi::PERM ? ((R & ~31) + perm32(R & 31)) : R;
        voffA[i] = (unsigned)(R * K + C) * 2u; voffB[i] = (unsigned)(Rb * K + C) * 2u; }
    const size_t kstep = (size_t)(BK * 2);
    const size_t hstep = (size_t)HALF * K * 2;
    const size_t tstep = 2 * hstep;
    const unsigned ldsw = (unsigned)wid * 1024u;
    const int aoff = lds_byte(wr * 64 + fr, fq * 8), boff = lds_byte(wc * 32 + fr, fq * 8);
#define PG8_SA(b, h) (((b) * 2 + (h)) * HTB)
#define PG8_SB(b, h) ((4 + (b) * 2 + (h)) * HTB)
#define PG8_STAGE(bufoff, gbase, voff) do { _Pragma("unroll") for (int _i = 0; _i < 2; ++_i) \
        __builtin_amdgcn_global_load_lds((const unsigned*)((const char*)(gbase) + (voff)[_i]), (PG8_LAS unsigned*)(lds + (bufoff) + ldsw + _i * 8192), 16, 0, 0); } while (0)
#define PG8_LDA(dst, b, h) do { _Pragma("unroll") for (int m = 0; m < 4; ++m) _Pragma("unroll") for (int k = 0; k < 2; ++k) dst[m][k] = *(const PG8_LAS bf16x8*)(lds + PG8_SA(b, h) + aoff + m * 2048 + k * 1024); } while (0)
#define PG8_LDB(dst, b, h) do { _Pragma("unroll") for (int n = 0; n < 2; ++n) _Pragma("unroll") for (int k = 0; k < 2; ++k) dst[n][k] = *(const PG8_LAS bf16x8*)(lds + PG8_SB(b, h) + boff + n * 2048 + k * 1024); } while (0)
#define PG8_MMA(ai, bj, At, Bt) do { __builtin_amdgcn_s_setprio(1); _Pragma("unroll") for (int m = 0; m < 4; ++m) _Pragma("unroll") for (int n = 0; n < 2; ++n) _Pragma("unroll") for (int k = 0; k < 2; ++k) \
        acc[ai][bj][m][n] = __builtin_amdgcn_mfma_f32_16x16x32_bf16(Bt[n][k], At[m][k], acc[ai][bj][m][n], 0, 0, 0); __builtin_amdgcn_s_setprio(0); } while (0)
#define PG8_WAIT_V(n) asm volatile("s_waitcnt vmcnt(" #n ")" ::: "memory")
#define PG8_WAIT_L(n) asm volatile("s_waitcnt lgkmcnt(" #n ")" ::: "memory")
#define PG8_BAR __builtin_amdgcn_s_barrier()
#define PG8_SCHED __builtin_amdgcn_sched_barrier(0)
    Unit cur, nxt; int ui = 0;
    if (!S.next(0, cur)) return;
    f32x4 acc[2][2][4][2];
#pragma unroll
    for (int a = 0; a < 2; ++a)
#pragma unroll
        for (int b = 0; b < 2; ++b)
#pragma unroll
            for (int m = 0; m < 4; ++m)
#pragma unroll
                for (int n = 0; n < 2; ++n) acc[a][b][m][n] = (f32x4){0.f, 0.f, 0.f, 0.f};
    bf16x8 At[4][2], B0[2][2], B1[2][2];
    const char* cA = (const char*)g.A + (size_t)cur.pm * tstep; const char* cB = (const char*)g.Bt + (size_t)cur.pn * tstep;
    S.a_ready(cur);
    if constexpr (SP2) {
        PG8_STAGE(PG8_SB(0, 0), cB, voffB); PG8_STAGE(PG8_SB(0, 1), cB + hstep, voffB); PG8_STAGE(PG8_SA(0, 0), cA, voffA); PG8_STAGE(PG8_SA(0, 1), cA + hstep, voffA);
        if (wr == 1) PG8_BAR;
        PG8_WAIT_V(2); PG8_BAR;
        PG8_STAGE(PG8_SB(1, 0), cB + kstep, voffB); PG8_STAGE(PG8_SA(1, 0), cA + kstep, voffA); PG8_STAGE(PG8_SB(1, 1), cB + hstep + kstep, voffB);
        PG8_WAIT_V(6); PG8_BAR;
    } else {
        PG8_STAGE(PG8_SB(0, 0), cB, voffB); PG8_STAGE(PG8_SA(0, 0), cA, voffA); PG8_STAGE(PG8_SB(0, 1), cB + hstep, voffB); PG8_STAGE(PG8_SA(0, 1), cA + hstep, voffA);
        if (wr == 1) PG8_BAR;
        PG8_WAIT_V(4); PG8_BAR;
        PG8_STAGE(PG8_SB(1, 0), cB + kstep, voffB); PG8_STAGE(PG8_SA(1, 0), cA + kstep, voffA); PG8_STAGE(PG8_SB(1, 1), cB + hstep + kstep, voffB);
        PG8_WAIT_V(6); PG8_BAR;
    }
    for (;;) {
        const bool has_next = S.next(ui + 1, nxt);
        const char* nA = has_next ? (const char*)g.A + (size_t)nxt.pm * tstep : cA; const char* nB = has_next ? (const char*)g.Bt + (size_t)nxt.pn * tstep : cB;
        for (int t = 0; t < nt; t += 2) {
            const bool last = (t == nt - 2);
            const char* a1 = cA + (size_t)(t + 1) * kstep;
            const char* a2 = last ? nA : cA + (size_t)(t + 2) * kstep; const char* b2 = last ? nB : cB + (size_t)(t + 2) * kstep;
            const char* a3 = a2 + kstep; const char* b3 = b2 + kstep;
            if (last && has_next) S.a_ready(nxt);
            if constexpr (SP2) {
            PG8_LDB(B0, 0, 0); PG8_LDB(B1, 0, 1); PG8_SCHED; PG8_LDA(At, 0, 0); PG8_STAGE(PG8_SA(1, 1), a1 + hstep, voffA);
            PG8_WAIT_V(8); PG8_WAIT_L(0); PG8_BAR; PG8_MMA(0, 0, At, B0); PG8_MMA(0, 1, At, B1); PG8_BAR; PG8_SCHED;
            PG8_LDA(At, 0, 1); PG8_STAGE(PG8_SB(0, 0), b2, voffB); PG8_STAGE(PG8_SB(0, 1), b2 + hstep, voffB); PG8_STAGE(PG8_SA(0, 0), a2, voffA);
            PG8_WAIT_V(8); PG8_WAIT_L(0); PG8_BAR; PG8_MMA(1, 0, At, B0); PG8_MMA(1, 1, At, B1); PG8_BAR; PG8_SCHED;
            PG8_LDB(B0, 1, 0); PG8_LDB(B1, 1, 1); PG8_SCHED; PG8_LDA(At, 1, 0); PG8_STAGE(PG8_SA(0, 1), a2 + hstep, voffA);
            PG8_WAIT_V(8); PG8_WAIT_L(0); PG8_BAR; PG8_MMA(0, 0, At, B0); PG8_MMA(0, 1, At, B1); PG8_BAR; PG8_SCHED;
            PG8_LDA(At, 1, 1); PG8_STAGE(PG8_SB(1, 0), b3, voffB); PG8_STAGE(PG8_SB(1, 1), b3 + hstep, voffB); PG8_STAGE(PG8_SA(1, 0), a3, voffA);
            PG8_WAIT_V(8); PG8_WAIT_L(0); PG8_BAR; PG8_MMA(1, 0, At, B0); PG8_MMA(1, 1, At, B1); PG8_BAR; PG8_SCHED;
            } else {
            PG8_LDB(B0, 0, 0); PG8_SCHED; PG8_LDA(At, 0, 0); PG8_STAGE(PG8_SA(1, 1), a1 + hstep, voffA);
            PG8_WAIT_L(8); PG8_BAR; PG8_WAIT_L(0); PG8_MMA(0, 0, At, B0); PG8_BAR; PG8_SCHED;
            PG8_LDB(B1, 0, 1); PG8_STAGE(PG8_SB(0, 0), b2, voffB);
            PG8_BAR; PG8_WAIT_L(0); PG8_MMA(0, 1, At, B1); PG8_BAR;
            PG8_LDA(At, 0, 1); PG8_STAGE(PG8_SA(0, 0), a2, voffA);
            PG8_BAR; PG8_WAIT_L(0); PG8_MMA(1, 0, At, B0); PG8_BAR; PG8_SCHED;
            PG8_STAGE(PG8_SB(0, 1), b2 + hstep, voffB);
            PG8_WAIT_V(6); PG8_BAR; PG8_MMA(1, 1, At, B1); PG8_BAR;
            PG8_LDB(B0, 1, 0); PG8_SCHED; PG8_LDA(At, 1, 0); PG8_STAGE(PG8_SA(0, 1), a2 + hstep, voffA);
            PG8_WAIT_L(8); PG8_BAR; PG8_WAIT_L(0); PG8_MMA(0, 0, At, B0); PG8_BAR; PG8_SCHED;
            PG8_LDB(B1, 1, 1); PG8_STAGE(PG8_SB(1, 0), b3, voffB);
            PG8_BAR; PG8_WAIT_L(0); PG8_MMA(0, 1, At, B1); PG8_BAR;
            PG8_LDA(At, 1, 1); PG8_STAGE(PG8_SA(1, 0), a3, voffA);
            PG8_BAR; PG8_WAIT_L(0); PG8_MMA(1, 0, At, B0); PG8_BAR; PG8_SCHED;
            PG8_STAGE(PG8_SB(1, 1), b3 + hstep, voffB);
            PG8_WAIT_V(6); PG8_BAR; PG8_MMA(1, 1, At, B1); PG8_BAR;
            }
        }
        if constexpr (ALIGN_EPI) { if (wr == 0) PG8_BAR; }
        if constexpr (!Epi::AFTER_DRAIN) { E(acc, cur, wr, wc, fr, fq); S.done(cur); }
        if (!has_next) break;
#pragma unroll
        for (int a = 0; a < 2; ++a)
#pragma unroll
            for (int b = 0; b < 2; ++b)
#pragma unroll
                for (int m = 0; m < 4; ++m)
#pragma unroll
                    for (int n = 0; n < 2; ++n) acc[a][b][m][n] = (f32x4){0.f, 0.f, 0.f, 0.f};
        cur = nxt; cA = nA; cB = nB; ++ui;
        if constexpr (ALIGN_EPI) { if (wr == 1) PG8_BAR; }
    }
    PG8_WAIT_V(0);
    if constexpr (!ALIGN_EPI) { if (wr == 0) PG8_BAR; }
    PG8_BAR;
    if constexpr (Epi::AFTER_DRAIN) { E.fused(acc, cur, wr, wc, fr, fq, lds, wid, lane); S.done(cur); }
#undef PG8_SA
#undef PG8_SB
#undef PG8_STAGE
#undef PG8_LDA
#undef PG8_LDB
#undef PG8_MMA
#undef PG8_WAIT_V
#undef PG8_WAIT_L
#undef PG8_BAR
#undef PG8_SCHED
}
}

constexpr int BATCH = 8, SEQ = 4096, DM = 1024, TOK = BATCH * SEQ, DIN = 3072, DFF = 2816, NH = 8, HD = 64;
constexpr float EPS = 1e-6f;
constexpr float QSCALE = 0.125f * 1.4426950408889634f;
constexpr int C_QA = 0, C_KA = 512, C_VA = 1024, C_QS = 1536, C_KS = 2048, C_VS = 2560;
constexpr size_t SLAB = (size_t)TOK * 512;

constexpr size_t MiB = 1u << 20;
constexpr size_t WS_CTL = 0;
constexpr size_t WS_WIN = 1 * MiB, WS_WOUT = 7 * MiB, WS_WGU = 9 * MiB, WS_WD = 20 * MiB;
constexpr size_t WS_ROPE = 26 * MiB;
constexpr size_t WS_SSQ = 27 * MiB;
constexpr size_t WS_LSE = 29 * MiB;
constexpr size_t WS_XN = 32 * MiB;
constexpr size_t WS_QKV = 96 * MiB;
constexpr size_t WS_ACT = 96 * MiB;
constexpr size_t WS_MIX = 288 * MiB;
constexpr size_t WS_MIXN = 96 * MiB;
constexpr size_t WS_DILO = 352 * MiB;
constexpr size_t WS_END = 448 * MiB;

constexpr int NWAVES = 8;
constexpr int RING_BYTES = 131072;
constexpr int LDS_BYTES = 147456;

#define LAS __attribute__((address_space(3)))
typedef unsigned short bf16;
__device__ __forceinline__ const bf16* head_base(const bf16* QKV, int slab, int b, int h) { return QKV + (size_t)slab * SLAB + (size_t)(b * NH + h) * (SEQ * HD); }
typedef float f32x4 __attribute__((ext_vector_type(4)));
typedef float f32x16 __attribute__((ext_vector_type(16)));
typedef short bf16x8 __attribute__((ext_vector_type(8)));
typedef short s16x4 __attribute__((ext_vector_type(4)));
typedef _Float16 f16x8 __attribute__((ext_vector_type(8)));
typedef unsigned u32x4 __attribute__((ext_vector_type(4)));
typedef unsigned u32x2 __attribute__((ext_vector_type(2)));

__device__ __forceinline__ unsigned f2bf(float f) { unsigned u = __builtin_bit_cast(unsigned, f); return (u + 0x7fffu + ((u >> 16) & 1u)) >> 16; }
__device__ __forceinline__ unsigned pk2(float lo, float hi) { return pg8::cvt_pk_bf16(lo, hi); }
__device__ __forceinline__ float bf_lo(unsigned w) { return __builtin_bit_cast(float, w << 16); }
__device__ __forceinline__ float bf_hi(unsigned w) { return __builtin_bit_cast(float, w & 0xffff0000u); }
__device__ __forceinline__ int crow(int r, int hi) { return (r & 3) + 8 * (r >> 2) + 4 * hi; }
__device__ __forceinline__ s16x4 vtr(LAS const unsigned char* p) { return __builtin_bit_cast(s16x4, __builtin_amdgcn_ds_read_tr16_b64_v4i16((LAS s16x4*)p)); }
#define MFMA_BF16(a, b, c) __builtin_amdgcn_mfma_f32_32x32x16_bf16((a), (b), (c), 0, 0, 0)
#define MFMA_F16(a, b, c) __builtin_amdgcn_mfma_f32_32x32x16_f16((a), (b), (c), 0, 0, 0)

struct Args {
    const float* x; const float* attn_norm_w; const float* w_in; const float* q_norm_w; const float* k_norm_w; const float* dil_norm_w; const float* sb_norm_w;
    const float* w_out; const float* ffn_norm_w; const float* w_gate; const float* w_up; const float* w_down;
    float* out; unsigned char* ws; int ph_lo, ph_hi;
};
#define XB_TMO      128
#define XB_XCNT(j)  (256  + 64 * (j))
#define XB_XSUB(j)  (1280 + 64 * (j))
#define XB_XGEN(j)  (2304 + 64 * (j))
#define XB_TOP      3328
#define XB_TOPGEN   3392
#define XCD_BAR_WORDS 3456
#define XB_SPIN_CAP (1u << 18)

__device__ __forceinline__ unsigned xb_ld(unsigned* p)              { return __hip_atomic_load(p, __ATOMIC_RELAXED, __HIP_MEMORY_SCOPE_AGENT); }
__device__ __forceinline__ unsigned xb_add(unsigned* p, unsigned v) { return __hip_atomic_fetch_add(p, v, __ATOMIC_RELAXED, __HIP_MEMORY_SCOPE_AGENT); }
__device__ __forceinline__ unsigned xb_xcc_id() { return (unsigned)__builtin_amdgcn_s_getreg((3 << 11) | 20) & 0xFu; }
#define XB_SPIN(cond, bar) do { unsigned _sp = 0; while (cond) { __builtin_amdgcn_s_sleep(1); \
    if ((++_sp & 255u) == 0u) { if (xb_ld(&(bar)[XB_TMO])) break; if (_sp > XB_SPIN_CAP) { atomicAdd(&(bar)[XB_TMO], 1u); break; } } } } while (0)

struct XcdBarrier {
    unsigned* bar; unsigned x;
    volatile LAS unsigned* st;
};

__device__ __forceinline__ XcdBarrier xcd_barrier_post(unsigned* bar, volatile LAS unsigned* st) {
    XcdBarrier b; b.bar = bar; b.x = xb_xcc_id(); b.st = st;
    if (threadIdx.x == 0) (void)xb_add(&bar[XB_XCNT(b.x)], 1u);
    return b;
}
__device__ __forceinline__ void xcd_barrier_complete(unsigned* bar, unsigned x, unsigned& nloc, unsigned& nx) {
    const unsigned G = gridDim.x * gridDim.y * gridDim.z;
    unsigned sum, cnt, mine, sp = 0u;
    for (;;) {
        sum = 0u; cnt = 0u; mine = 0u;
#pragma unroll
        for (unsigned j = 0; j < 16; ++j) { const unsigned c = xb_ld(&bar[XB_XCNT(j)]); sum += c; cnt += (c > 0u) ? 1u : 0u; mine = (j == x) ? c : mine; }
        if (sum == G) break;
        __builtin_amdgcn_s_sleep(1);
        if ((++sp & 255u) == 0u) { if (xb_ld(&bar[XB_TMO])) break; if (sp > XB_SPIN_CAP) { atomicAdd(&bar[XB_TMO], 1u); break; } }
    }
    nloc = mine > 0u ? mine : 1u; nx = cnt > 0u ? cnt : 1u;
}

__device__ __forceinline__ void xcd_barrier(const XcdBarrier& b) {
    asm volatile("s_waitcnt vmcnt(0)" ::: "memory");
    __syncthreads();
    if (threadIdx.x == 0) {
        unsigned* bar = b.bar;
        __builtin_amdgcn_s_waitcnt(0);
        unsigned nloc = b.st[0], nx = b.st[1];
        if (nloc == 0u) { xcd_barrier_complete(bar, b.x, nloc, nx); b.st[0] = nloc; b.st[1] = nx; }
        const unsigned old = xb_add(&bar[XB_XSUB(b.x)], 1u);
        const unsigned gen = old / nloc;
        if (old + 1u == (gen + 1u) * nloc) {
            __builtin_amdgcn_fence(__ATOMIC_RELEASE, "agent");
            asm volatile("s_waitcnt vmcnt(0)" ::: "memory");
            const unsigned og = xb_add(&bar[XB_TOP], 1u);
            const unsigned tg = og / nx;
            if (og + 1u == (tg + 1u) * nx) xb_add(&bar[XB_TOPGEN], 1u);
            else XB_SPIN(xb_ld(&bar[XB_TOPGEN]) == tg, bar);
            __builtin_amdgcn_fence(__ATOMIC_ACQUIRE, "agent");
            xb_add(&bar[XB_XGEN(b.x)], 1u);
            asm volatile("s_waitcnt vmcnt(0)" ::: "memory");
        } else {
            XB_SPIN(xb_ld(&bar[XB_XGEN(b.x)]) == gen, bar);
            __builtin_amdgcn_fence(__ATOMIC_ACQUIRE, "agent");
            asm volatile("s_waitcnt vmcnt(0)" ::: "memory");
        }
    }
    __syncthreads();
}

template <int MODE>
__device__ __forceinline__ void p0_transpose_item(const float* __restrict__ W, int K, int N, bf16* __restrict__ WT, const float* __restrict__ kscale, LAS float* scr, int item, int lane) {
    const int nblk = N / 32, kb = item / nblk, nb = item % nblk, k0 = 64 * kb, n0 = 32 * nb;
    const int c = lane & 7;
    f32x4 ks0 = {1.f, 1.f, 1.f, 1.f}, ks1 = ks0;
    if (kscale) { ks0 = *(const f32x4*)(kscale + k0 + 8 * c); ks1 = *(const f32x4*)(kscale + k0 + 8 * c + 4); }
    float wv[32];
#pragma unroll
    for (int i = 0; i < 32; ++i) wv[i] = W[(size_t)(k0 + 2 * i + (lane >> 5)) * N + n0 + (lane & 31)];
#pragma unroll
    for (int i = 0; i < 32; ++i) scr[(2 * i + (lane >> 5)) * 33 + (lane & 31)] = wv[i];
    asm volatile("s_waitcnt lgkmcnt(0)" ::: "memory");
#pragma unroll
    for (int j = 0; j < 4; ++j) { const int n = (lane >> 3) + 8 * j; const LAS float* s = scr + (8 * c) * 33 + n;
        u32x4 o; o.x = pk2(s[0 * 33] * ks0[0], s[1 * 33] * ks0[1]); o.y = pk2(s[2 * 33] * ks0[2], s[3 * 33] * ks0[3]); o.z = pk2(s[4 * 33] * ks1[0], s[5 * 33] * ks1[1]); o.w = pk2(s[6 * 33] * ks1[2], s[7 * 33] * ks1[3]);
        const int ng = n0 + n; const int row = (MODE == 0) ? ng : (MODE == 3) ? ((ng & ~255) + 128 * ((ng >> 5) & 1) + 32 * ((ng >> 6) & 3) + (ng & 31)) : (256 * (ng >> 7) + (ng & 127) + (MODE == 2 ? 128 : 0));
        *(u32x4*)(WT + (size_t)row * K + k0 + 8 * c) = o; }
    asm volatile("s_waitcnt lgkmcnt(0)" ::: "memory");
}
__device__ __forceinline__ float wave_sum(float v) {
#pragma unroll
    for (int o = 1; o < 64; o <<= 1) v += __shfl_xor(v, o);
    return v;
}
__device__ __forceinline__ void p0_prologue(const Args& A, LAS unsigned char* lds, int vcu, int G, int wave, int lane) {
    LAS float* scr = (LAS float*)(lds + wave * 16384);
    const int gw = vcu * NWAVES + wave, NGW = G * NWAVES;
    unsigned char* ws = A.ws;
    constexpr int I_IN = (DM / 64) * (DIN / 32), I_OUT = (DM / 64) * (DM / 32), I_G = (DM / 64) * (DFF / 32), I_D = (DFF / 64) * (DM / 32);
    constexpr int NITEMS = I_IN + I_OUT + 2 * I_G + I_D;
    for (int it = gw; it < NITEMS; it += NGW) {
        int r = it;
        if (r < I_IN) { p0_transpose_item<3>(A.w_in, DM, DIN, (bf16*)(ws + WS_WIN), nullptr, scr, r, lane); continue; } r -= I_IN;
        if (r < I_OUT) { p0_transpose_item<0>(A.w_out, DM, DM, (bf16*)(ws + WS_WOUT), nullptr, scr, r, lane); continue; } r -= I_OUT;
        if (r < I_G) { p0_transpose_item<1>(A.w_gate, DM, DFF, (bf16*)(ws + WS_WGU), A.ffn_norm_w, scr, r, lane); continue; } r -= I_G;
        if (r < I_G) { p0_transpose_item<2>(A.w_up, DM, DFF, (bf16*)(ws + WS_WGU), A.ffn_norm_w, scr, r, lane); continue; } r -= I_G;
        p0_transpose_item<0>(A.w_down, DFF, DM, (bf16*)(ws + WS_WD), nullptr, scr, r, lane);
    }
    {
        float* ct = (float*)(ws + WS_ROPE); float* st = ct + SEQ * 32;
        for (int idx = gw * 64 + lane; idx < SEQ * 32; idx += NGW * 64) {
            const int pos = idx >> 5, j = idx & 31;
            const float inv = __builtin_amdgcn_exp2f(-(float)j * (13.287712379549449f / 32.0f));
            const float ang = (float)pos * inv;
            double t = (double)ang * 0.15915494309189535; t -= __builtin_rint(t);
            ct[idx] = __builtin_amdgcn_cosf((float)t); st[idx] = __builtin_amdgcn_sinf((float)t);
        }
    }
    bf16* XN = (bf16*)(ws + WS_XN);
    f32x4 wg[4];
#pragma unroll
    for (int j = 0; j < 4; ++j) wg[j] = ((const f32x4*)A.attn_norm_w)[lane + 64 * j];
    for (int m0 = gw * 4; m0 < TOK; m0 += NGW * 4) {
        f32x4 v[4][4];
#pragma unroll
        for (int u = 0; u < 4; ++u) { const f32x4* xr = (const f32x4*)(A.x + (size_t)(m0 + u) * DM) + lane;
#pragma unroll
            for (int j = 0; j < 4; ++j) v[u][j] = __builtin_nontemporal_load(xr + 64 * j); }
#pragma unroll
        for (int u = 0; u < 4; ++u) { float s = 0.f;
#pragma unroll
            for (int j = 0; j < 4; ++j) s += (v[u][j].x * v[u][j].x + v[u][j].y * v[u][j].y) + (v[u][j].z * v[u][j].z + v[u][j].w * v[u][j].w);
            const float rs = 1.f / sqrtf(wave_sum(s) * (1.f / DM) + EPS);
            u32x2* o8 = (u32x2*)(XN + (size_t)(m0 + u) * DM) + lane;
#pragma unroll
            for (int j = 0; j < 4; ++j) { const f32x4 w = wg[j]; u32x2 o; o.x = pk2(v[u][j].x * rs * w.x, v[u][j].y * rs * w.y); o.y = pk2(v[u][j].z * rs * w.z, v[u][j].w * rs * w.w); o8[64 * j] = o; } }
    }
}

__device__ __forceinline__ void stage_rows(LAS unsigned char* st, const f32x16& o0, const f32x16& o1, float scale, int lane) {
    const int r32 = lane & 31, hi = lane >> 5;
#pragma unroll
    for (int g = 0; g < 4; ++g) {
        u32x2 a, c; a.x = pk2(o0[4 * g] * scale, o0[4 * g + 1] * scale); a.y = pk2(o0[4 * g + 2] * scale, o0[4 * g + 3] * scale); c.x = pk2(o1[4 * g] * scale, o1[4 * g + 1] * scale); c.y = pk2(o1[4 * g + 2] * scale, o1[4 * g + 3] * scale);
        *(LAS u32x2*)(st + r32 * 144 + (8 * g + 4 * hi) * 2) = a; *(LAS u32x2*)(st + r32 * 144 + 64 + (8 * g + 4 * hi) * 2) = c;
    }
    asm volatile("s_waitcnt lgkmcnt(0)" ::: "memory");
}
__device__ __forceinline__ u32x4 staged_chunk(LAS const unsigned char* st, int i, int lane) { return *(LAS const u32x4*)(st + (8 * i + (lane >> 3)) * 144 + (lane & 7) * 16); }

constexpr float SB_EXIT_BITS = 40.f;
template <bool MASK>
__device__ __forceinline__ void sb_tile(f32x16& o0, f32x16& o1, float& carry, const bf16x8 (&qr)[4], LAS const unsigned char* Kb, LAS const unsigned char* Vb, const f16x8& U0, const f16x8& U1, const f16x8& ONES,
                                        int kbase, int trow, int r32, int hi) {
    f32x16 p0 = {}, p1 = {};
    { bf16x8 ka[4], kb[4];
#pragma unroll
      for (int d0 = 0; d0 < 4; ++d0) { ka[d0] = *(LAS const bf16x8*)(Kb + d0 * 2048); kb[d0] = *(LAS const bf16x8*)(Kb + d0 * 2048 + 512); }
#pragma unroll
      for (int d0 = 0; d0 < 4; ++d0) { p0 = MFMA_BF16(ka[d0], qr[d0], p0); p1 = MFMA_BF16(kb[d0], qr[d0], p1); } }
    f32x16 s0, s1;
#pragma unroll
    for (int r = 0; r < 16; ++r) {
        const float z0 = __builtin_fminf(p0[r], 126.f), z1 = __builtin_fminf(p1[r], 126.f);
        p0[r] = z0; p1[r] = z1;
        float a = __builtin_amdgcn_logf(1.f + __builtin_amdgcn_exp2f(z0)), b = __builtin_amdgcn_logf(1.f + __builtin_amdgcn_exp2f(z1));
        if (MASK) { const int key = kbase + (r & 3) + 8 * (r >> 2); if (!(key < trow)) a = 0.f; if (!(key + 32 < trow)) b = 0.f; }
        s0[r] = a; s1[r] = b;
    }
    f16x8 h0a, h0b, h1a, h1b;
#pragma unroll
    for (int i = 0; i < 8; ++i) { h0a[i] = (_Float16)s0[i]; h0b[i] = (_Float16)s0[8 + i]; h1a[i] = (_Float16)s1[i]; h1b[i] = (_Float16)s1[8 + i]; }
    f32x16 ci;
#pragma unroll
    for (int r = 0; r < 16; ++r) ci[r] = carry;
    f32x16 c1 = MFMA_F16(U0, h1a, ci); c1 = MFMA_F16(U1, h1b, c1);
    f32x16 c0 = MFMA_F16(ONES, h1a, ci); c0 = MFMA_F16(ONES, h1b, c0); c0 = MFMA_F16(U0, h0a, c0); c0 = MFMA_F16(U1, h0b, c0);
    carry = __shfl(c0[0], r32);
#pragma unroll
    for (int r = 0; r < 16; ++r) {
        float a = __builtin_amdgcn_exp2f(p0[r] - c0[r]), b = __builtin_amdgcn_exp2f(p1[r] - c1[r]);
        if (MASK) { const int key = kbase + (r & 3) + 8 * (r >> 2); if (!(key < trow)) a = 0.f; if (!(key + 32 < trow)) b = 0.f; }
        p0[r] = a; p1[r] = b;
    }
    u32x4 w[4];
#pragma unroll
    for (int i = 0; i < 4; ++i) { w[0][i] = pk2(p0[2 * i], p0[2 * i + 1]); w[1][i] = pk2(p0[8 + 2 * i], p0[8 + 2 * i + 1]); w[2][i] = pk2(p1[2 * i], p1[2 * i + 1]); w[3][i] = pk2(p1[8 + 2 * i], p1[8 + 2 * i + 1]); }
    bf16x8 va[4], vb4[4];
#pragma unroll
    for (int kk = 0; kk < 4; ++kk) {
        const s16x4 lo = vtr(Vb + kk * 1024), hh = vtr(Vb + kk * 1024 + 512), l2 = vtr(Vb + 4096 + kk * 1024), h2 = vtr(Vb + 4096 + kk * 1024 + 512);
        va[kk] = (bf16x8){lo[0], lo[1], lo[2], lo[3], hh[0], hh[1], hh[2], hh[3]}; vb4[kk] = (bf16x8){l2[0], l2[1], l2[2], l2[3], h2[0], h2[1], h2[2], h2[3]};
    }
#pragma unroll
    for (int kk = 0; kk < 4; ++kk) { const bf16x8 pf = __builtin_bit_cast(bf16x8, w[kk]); o0 = MFMA_BF16(va[kk], pf, o0); o1 = MFMA_BF16(vb4[kk], pf, o1); }
}

constexpr int SB_STAGE = 98304, SB_STAT = 135168;
__device__ __forceinline__ void sb_unit(int b, int h, int qb, const bf16* __restrict__ QKV, bf16* __restrict__ MIX, LAS unsigned char* lds) {
    const int tid = threadIdx.x, lane = tid & 63, r32 = lane & 31, hi = lane >> 5;
    const int wid = __builtin_amdgcn_readfirstlane(tid >> 6);
    const size_t rowbase = (size_t)b * SEQ;
    const int q0 = qb * 256, wrow0 = q0 + wid * 32, trow = wrow0 + r32;
    bf16x8 qr[4];
    { const bf16* Qp = head_base(QKV, 3, b, h) + (size_t)trow * HD + hi * 8;
#pragma unroll
      for (int d0 = 0; d0 < 4; ++d0) qr[d0] = *(const bf16x8*)(Qp + d0 * 16); }
    const bf16* Ksrc = head_base(QKV, 4, b, h) + (size_t)lane * HD + wid * 8;
    const bf16* Vsrc = head_base(QKV, 5, b, h) + (size_t)(16 * (wid & 3) + (lane >> 2)) * HD + (wid >> 2) * 32 + (lane & 3) * 8;
    const int stoff = wid * 1024 + lane * 16;
    const int kt0 = 4 * qb - 2;
    const int kbot = kt0 < 0 ? 0 : kt0;
    { u32x4 kr[6], vr[6];
#pragma unroll
      for (int sl = 0; sl < 6; ++sl) if (kt0 + sl >= 0) { kr[sl] = *(const u32x4*)(Ksrc + (size_t)(kt0 + sl) * 64 * HD); vr[sl] = *(const u32x4*)(Vsrc + (size_t)(kt0 + sl) * 64 * HD); }
#pragma unroll
      for (int sl = 0; sl < 6; ++sl) if (kt0 + sl >= 0) { *(LAS u32x4*)(lds + sl * 16384 + stoff) = kr[sl]; *(LAS u32x4*)(lds + sl * 16384 + 8192 + stoff) = vr[sl]; } }
    f16x8 U0, U1, ONES;
#pragma unroll
    for (int i = 0; i < 8; ++i) { const int j = (i & 3) + 8 * (i >> 2) + 4 * hi; U0[i] = (j >= r32) ? (_Float16)1.f : (_Float16)0.f; U1[i] = (j + 16 >= r32) ? (_Float16)1.f : (_Float16)0.f; ONES[i] = (_Float16)1.f; }
    __syncthreads();
    float carry = 0.f; f32x16 o0 = {}, o1 = {}; bool wfin = false;
    const int kfo = hi * 1024 + r32 * 16;
    const int vbo = ((lane >> 4) & 1) * 32 + (lane & 3) * 8 + (4 * hi + ((lane & 15) >> 2)) * 64;
#pragma unroll 1
    for (int kt = (wrow0 + 30) >> 6; kt >= kbot; --kt) {
        const int sl = kt - kt0;
        LAS const unsigned char* Kb = lds + sl * 16384 + kfo; LAS const unsigned char* Vb = lds + sl * 16384 + 8192 + vbo;
        const int kbase = 64 * kt + 4 * hi;
        if (64 * kt + 63 >= wrow0) sb_tile<true>(o0, o1, carry, qr, Kb, Vb, U0, U1, ONES, kbase, trow, r32, hi);
        else sb_tile<false>(o0, o1, carry, qr, Kb, Vb, U0, U1, ONES, kbase, trow, r32, hi);
        if (__all(carry > SB_EXIT_BITS)) { wfin = true; break; }
    }
    if (kbot == 0) wfin = true;
    LAS unsigned* stat = (LAS unsigned*)(lds + SB_STAT);
    if (lane == 0) stat[16 + wid] = wfin ? 1u : 0u;
    __syncthreads();
    bool alldone;
    { const u32x4 sa = *(LAS const u32x4*)(stat + 16), sb4 = *(LAS const u32x4*)(stat + 20); alldone = (sa.x & sa.y & sa.z & sa.w & sb4.x & sb4.y & sb4.z & sb4.w) != 0u; }
    if (!alldone) {
        const int NT = kt0;
        __syncthreads();
        u32x4 kreg = *(const u32x4*)(Ksrc + (size_t)(NT - 1) * 64 * HD), vreg = *(const u32x4*)(Vsrc + (size_t)(NT - 1) * 64 * HD);
        *(LAS u32x4*)(lds + stoff) = kreg; *(LAS u32x4*)(lds + 16384 + stoff) = vreg;
        __syncthreads();
#pragma unroll 1
        for (int it = 0; it < NT; ++it) {
            const int kt = NT - 1 - it, cur = it & 1;
            const bool more = it + 1 < NT;
            if (more) { kreg = *(const u32x4*)(Ksrc + (size_t)(kt - 1) * 64 * HD); vreg = *(const u32x4*)(Vsrc + (size_t)(kt - 1) * 64 * HD); }
            if (!wfin) {
                LAS const unsigned char* Kb = lds + cur * 8192 + kfo; LAS const unsigned char* Vb = lds + 16384 + cur * 8192 + vbo;
                sb_tile<false>(o0, o1, carry, qr, Kb, Vb, U0, U1, ONES, 64 * kt + 4 * hi, trow, r32, hi);
            }
            if (more) { *(LAS u32x4*)(lds + (cur ^ 1) * 8192 + stoff) = kreg; *(LAS u32x4*)(lds + 16384 + (cur ^ 1) * 8192 + stoff) = vreg; }
            wfin = __all(carry > SB_EXIT_BITS) != 0;
            if (lane == 0) stat[cur * 8 + wid] = wfin ? 1u : 0u;
            __syncthreads();
            const u32x4 sa = *(LAS const u32x4*)(stat + cur * 8), sb4 = *(LAS const u32x4*)(stat + cur * 8 + 4);
            if ((sa.x & sa.y & sa.z & sa.w & sb4.x & sb4.y & sb4.z & sb4.w) != 0u) break;
        }
    }
    { LAS unsigned char* st = lds + SB_STAGE + wid * 4608;
      stage_rows(st, o0, o1, 1.f, lane);
      bf16* Op = MIX + (rowbase + wrow0) * DM + 512 + h * 64 + (lane & 7) * 8;
#pragma unroll
      for (int i = 0; i < 4; ++i) *(u32x4*)(Op + (size_t)(8 * i + (lane >> 3)) * DM) = staged_chunk(st, i, lane);
      asm volatile("s_waitcnt lgkmcnt(0)" ::: "memory"); }
    __syncthreads();
}

struct DilCtx { const bf16* kbase; int lr, c, pb, r32, hi, lane, c8, vst, vbo, kst, kfo; };
constexpr int DIL_KOFF = 4096, DIL_KPITCH = 528, DIL_WL = 8704;
__device__ __forceinline__ void dil_load_group(const DilCtx& X, int G, u32x4 (&kr)[4], u32x4 (&vr)[4]) {
    const int pos0 = 32 * (X.pb - 4 + G);
#pragma unroll
    for (int j = 0; j < 4; ++j) { const bf16* rowp = X.kbase + (size_t)(((pos0 + 8 * j + (X.lane >> 3)) << X.lr) + X.c) * HD + X.c8 * 8;
        kr[j] = *(const u32x4*)rowp; vr[j] = *(const u32x4*)(rowp + SLAB); }
}
template <bool fixed>
__device__ __forceinline__ void dil_step(const DilCtx& X, int G, u32x4 (&kr)[4], u32x4 (&vr)[4], const bf16x8 (&qr)[2][4], f32x16 (&o0)[2], f32x16 (&o1)[2], float (&mrun)[2], float (&lrun)[2], LAS unsigned char* wl) {
    const int r32 = X.r32, hi = X.hi;
#pragma unroll
    for (int j = 0; j < 4; ++j) { *(LAS u32x4*)(wl + X.vst + j * 512) = vr[j]; *(LAS u32x4*)(wl + X.kst + j * 128) = kr[j]; }
    if (G + 1 < 6) dil_load_group(X, G + 1, kr, vr);
    asm volatile("s_waitcnt lgkmcnt(0)" ::: "memory");
    bf16x8 kf[4];
#pragma unroll
    for (int d0 = 0; d0 < 4; ++d0) kf[d0] = *(LAS const bf16x8*)(wl + X.kfo + d0 * (2 * DIL_KPITCH));
#pragma unroll
    for (int u = 0; u < 2; ++u) {
        const int g = G - u;
        if (g >= 0 && g <= 4) {
            f32x16 pp = {};
#pragma unroll
            for (int d0 = 0; d0 < 4; ++d0) pp = MFMA_BF16(kf[d0], qr[u][d0], pp);
            if (g == 0) {
#pragma unroll
                for (int r = 0; r < 16; ++r) if (crow(r, hi) < r32) pp[r] = -INFINITY;
            } else if (g == 4) {
#pragma unroll
                for (int r = 0; r < 16; ++r) if (crow(r, hi) > r32) pp[r] = -INFINITY;
            }
            if (fixed) {
                float ls = 0.f;
#pragma unroll
                for (int r = 0; r < 16; ++r) { pp[r] = __builtin_amdgcn_exp2f(pp[r]); ls += pp[r]; }
                lrun[u] += ls;
            } else {
                float mx = pp[0];
#pragma unroll
                for (int r = 1; r < 16; ++r) mx = __builtin_fmaxf(mx, pp[r]);
                mx = __builtin_fmaxf(mx, __shfl_xor(mx, 32));
                const float mnew = __builtin_fmaxf(mrun[u], mx);
                const float alpha = __builtin_amdgcn_exp2f(mrun[u] - mnew);
                mrun[u] = mnew;
                float ls = 0.f;
#pragma unroll
                for (int r = 0; r < 16; ++r) { pp[r] = __builtin_amdgcn_exp2f(pp[r] - mnew); ls += pp[r]; }
                lrun[u] = lrun[u] * alpha + ls;
#pragma unroll
                for (int r = 0; r < 16; ++r) { o0[u][r] *= alpha; o1[u][r] *= alpha; }
            }
            u32x4 w[2];
#pragma unroll
            for (int i = 0; i < 4; ++i) { w[0][i] = pk2(pp[2 * i], pp[2 * i + 1]); w[1][i] = pk2(pp[8 + 2 * i], pp[8 + 2 * i + 1]); }
            LAS const unsigned char* vb = wl + X.vbo;
            bf16x8 va[2], vc[2];
#pragma unroll
            for (int kk = 0; kk < 2; ++kk) {
                const s16x4 lo = vtr(vb + kk * 1024), hh = vtr(vb + kk * 1024 + 512), l2 = vtr(vb + 2048 + kk * 1024), h2 = vtr(vb + 2048 + kk * 1024 + 512);
                va[kk] = (bf16x8){lo[0], lo[1], lo[2], lo[3], hh[0], hh[1], hh[2], hh[3]}; vc[kk] = (bf16x8){l2[0], l2[1], l2[2], l2[3], h2[0], h2[1], h2[2], h2[3]};
            }
#pragma unroll
            for (int kk = 0; kk < 2; ++kk) { const bf16x8 pf = __builtin_bit_cast(bf16x8, w[kk]); o0[u] = MFMA_BF16(va[kk], pf, o0[u]); o1[u] = MFMA_BF16(vc[kk], pf, o1[u]); }
        }
    }
    asm volatile("s_waitcnt lgkmcnt(0)" ::: "memory");
}
template <bool fixed>
__device__ __forceinline__ void dil_pair(int pairid, const bf16* __restrict__ QKV, bf16* __restrict__ DILO, float* __restrict__ LSE, LAS unsigned char* wl, int lane) {
    const int r32 = lane & 31, hi = lane >> 5;
    const int task = 2 * pairid;
    const int bh = task / 384, rem = task - bh * 384, idx = rem & 127, br = rem >> 7, h = bh & 7;
    const size_t rowbase = (size_t)(bh >> 3) * SEQ, hb = (size_t)bh * (SEQ * HD);
    const int lr = 2 * br;
    const int nbs = 128 >> lr;
    const int c = idx / nbs, pb = idx - c * nbs;
    bf16x8 qr[2][4];
#pragma unroll
    for (int u = 0; u < 2; ++u) {
        const int tq0 = (((32 * (pb + u) + r32) << lr) + c);
        const bf16* Qp = QKV + hb + (size_t)tq0 * HD + hi * 8;
#pragma unroll
        for (int d0 = 0; d0 < 4; ++d0) qr[u][d0] = *(const bf16x8*)(Qp + d0 * 16);
    }
    const int G_lo = (pb < 4) ? (4 - pb) : 0;
    DilCtx X; X.kbase = QKV + SLAB + hb; X.lr = lr; X.c = c; X.pb = pb; X.r32 = r32; X.hi = hi; X.lane = lane; X.c8 = lane & 7;
    X.vst = ((lane & 7) >> 2) * 2048 + (lane >> 3) * 64 + (lane & 3) * 16; X.vbo = ((lane >> 4) & 1) * 32 + (lane & 3) * 8 + (4 * hi + ((lane & 15) >> 2)) * 64;
    X.kst = DIL_KOFF + (lane & 7) * DIL_KPITCH + (lane >> 3) * 16;
    X.kfo = DIL_KOFF + hi * DIL_KPITCH + r32 * 16;
    const float m0 = fixed ? 0.f : -1e30f;
    float mrun[2] = {m0, m0}, lrun[2] = {0.f, 0.f}; f32x16 o0[2] = {}, o1[2] = {};
    u32x4 kr[4], vr[4];
    dil_load_group(X, G_lo, kr, vr);
#pragma unroll 1
    for (int G = G_lo; G < 6; ++G) dil_step<fixed>(X, G, kr, vr, qr, o0, o1, mrun, lrun, wl);
#pragma unroll
    for (int u = 0; u < 2; ++u) {
        const float lt = lrun[u] + __shfl_xor(lrun[u], 32);
        const float inv = __builtin_amdgcn_rcpf(lt);
        const int tqu = (((32 * (pb + u) + r32) << lr) + c);
        stage_rows(wl, o0[u], o1[u], inv, lane);
#pragma unroll
        for (int i = 0; i < 4; ++i) { const int tr = (((32 * (pb + u) + 8 * i + (lane >> 3)) << lr) + c);
            *(u32x4*)(DILO + ((size_t)br * TOK + rowbase + tr) * 512 + h * 64 + (lane & 7) * 8) = staged_chunk(wl, i, lane); }
        asm volatile("s_waitcnt lgkmcnt(0)" ::: "memory");
        if (hi == 0) LSE[((size_t)br * TOK + rowbase + tqu) * 8 + h] = mrun[u] + __builtin_amdgcn_logf(lt);
    }
}

__device__ __forceinline__ void p2c_merge_norm(const Args& A, int vcu, int G, int wave, int lane) {
    const int gw = vcu * NWAVES + wave, NGW = G * NWAVES;
    const bf16* DILO = (const bf16*)(A.ws + WS_DILO); const float* LSE = (const float*)(A.ws + WS_LSE); const bf16* MIX = (const bf16*)(A.ws + WS_MIX); bf16* MIXN = (bf16*)(A.ws + WS_MIXN);
    float wd[8], wsb[8];
#pragma unroll
    for (int i = 0; i < 8; ++i) { wd[i] = A.dil_norm_w[8 * lane + i]; wsb[i] = A.sb_norm_w[8 * lane + i]; }
    for (int m0 = gw * 4; m0 < TOK; m0 += NGW * 4) {
        u32x4 d[4][3], sv[4]; float ls[4][3];
#pragma unroll
        for (int u = 0; u < 4; ++u) { const size_t m = (size_t)(m0 + u);
#pragma unroll
            for (int br = 0; br < 3; ++br) { d[u][br] = *(const u32x4*)(DILO + ((size_t)br * TOK + m) * 512 + 8 * lane); ls[u][br] = LSE[((size_t)br * TOK + m) * 8 + (lane >> 3)]; }
            sv[u] = *(const u32x4*)(MIX + m * DM + 512 + 8 * lane); }
#pragma unroll
        for (int u = 0; u < 4; ++u) {
            const float mx = __builtin_fmaxf(ls[u][0], __builtin_fmaxf(ls[u][1], ls[u][2]));
            float w0 = __builtin_amdgcn_exp2f(ls[u][0] - mx), w1 = __builtin_amdgcn_exp2f(ls[u][1] - mx), w2 = __builtin_amdgcn_exp2f(ls[u][2] - mx);
            const float inv = 1.f / (w0 + w1 + w2); w0 *= inv; w1 *= inv; w2 *= inv;
            float v[8], x[8]; float sd = 0.f, sb = 0.f;
#pragma unroll
            for (int i = 0; i < 4; ++i) {
                v[2 * i] = w0 * bf_lo(d[u][0][i]) + w1 * bf_lo(d[u][1][i]) + w2 * bf_lo(d[u][2][i]); v[2 * i + 1] = w0 * bf_hi(d[u][0][i]) + w1 * bf_hi(d[u][1][i]) + w2 * bf_hi(d[u][2][i]);
                x[2 * i] = bf_lo(sv[u][i]); x[2 * i + 1] = bf_hi(sv[u][i]); }
#pragma unroll
            for (int i = 0; i < 8; ++i) { sd += v[i] * v[i]; sb += x[i] * x[i]; }
            const float rd = 1.f / sqrtf(wave_sum(sd) * (1.f / 512.f) + EPS), rb = 1.f / sqrtf(wave_sum(sb) * (1.f / 512.f) + EPS);
            u32x4 oa, ob;
#pragma unroll
            for (int i = 0; i < 4; ++i) { oa[i] = pk2(v[2 * i] * rd * wd[2 * i], v[2 * i + 1] * rd * wd[2 * i + 1]); ob[i] = pk2(x[2 * i] * rb * wsb[2 * i], x[2 * i + 1] * rb * wsb[2 * i + 1]); }
            bf16* q = MIXN + (size_t)(m0 + u) * DM + 8 * lane;
            *(u32x4*)q = oa; *(u32x4*)(q + 512) = ob;
        }
    }
}

#ifndef REP_P1
#define REP_P1 1
#endif
#ifndef REP_SB
#define REP_SB 1
#endif
#ifndef REP_DIL
#define REP_DIL 1
#endif
#ifndef REP_P0
#define REP_P0 1
#endif
#ifndef REP_P2C
#define REP_P2C 1
#endif
#ifndef REP_P3
#define REP_P3 1
#endif
#ifndef REP_P5
#define REP_P5 1
#endif
#ifndef REP_P4
#define REP_P4 1
#endif
__global__ void __launch_bounds__(NWAVES * 64, 2) hymba_fwd(Args args) {
    extern __shared__ __attribute__((aligned(16))) unsigned char lds_raw[];
    cg::grid_group grid = cg::this_grid();
    LAS unsigned char* lds = (LAS unsigned char*)lds_raw;
    const int tid = threadIdx.x, lane = tid & 63, wave = __builtin_amdgcn_readfirstlane(tid >> 6);
    const int G = gridDim.x; const int bx = blockIdx.x; const int vcu = (G % 8 == 0) ? (bx % 8) * (G / 8) + bx / 8 : bx;
    unsigned char* ws = args.ws;
    const int lo = args.ph_lo, hi = args.ph_hi;
#define IN(k) (lo <= (k) && (k) < hi)
#define SEAM(k) do { if (IN(k)) { if (hi > 1000) grid.sync(); else xcd_barrier(bar); } } while (0)
    if (tid < 64) ((LAS unsigned*)(lds + LDS_BYTES - 256))[tid] = 0u;
    __syncthreads();
    XcdBarrier bar = xcd_barrier_post((unsigned*)(ws + WS_CTL) + 4096, (volatile LAS unsigned*)(lds + LDS_BYTES - 256) + 8);

    if (IN(0)) { for (int rep = 0; rep < REP_P0; ++rep) p0_prologue(args, lds, vcu, G, wave, lane); }
    SEAM(0);
    if (IN(1)) {
#define P1_BODY { pg8::Gemm g{(const pg8::bf16_t*)(ws + WS_XN), (const pg8::bf16_t*)(ws + WS_WIN), TOK, DIN, DM}; pg8::StaticOrder S; S.init(TOK, DIN, G, bx); \
        pg8::EpiQKV E{(pg8::bf16_t*)(ws + WS_QKV), DIN, 2, 4, C_QS / 256, C_QS / 256 + 1, QSCALE, args.q_norm_w, args.k_norm_w, (const float*)(ws + WS_ROPE), (const float*)(ws + WS_ROPE) + SEQ * 32, EPS}; \
        pg8::gemm_phase<pg8::EpiQKV, pg8::StaticOrder, true, true>(lds, g, S, E); }
        P1_BODY
#if REP_P1 == 2
        asm volatile("" ::: "memory");
        P1_BODY
#endif
#undef P1_BODY
    }
    SEAM(1);
    if (IN(3)) {
        const bf16* QKV = (const bf16*)(ws + WS_QKV);
        for (int rep = 0; rep < REP_SB; ++rep)
        for (int v = vcu; v < 256; v += G) {
            const int s = v & 3, bh = v >> 2;
#pragma unroll 1
            for (int i = 0; i < 4; ++i) { const int qb = (i == 0) ? s : (i == 1) ? 7 - s : (i == 2) ? 8 + s : 15 - s; sb_unit(bh >> 3, bh & 7, qb, QKV, (bf16*)(ws + WS_MIX), lds); }
        }
        __syncthreads();
        bool dil_fixed;
        {
            float mq = __builtin_fabsf(args.q_norm_w[lane]), mk = __builtin_fabsf(args.k_norm_w[lane]);
#pragma unroll
            for (int o = 1; o < 64; o <<= 1) { mq = __builtin_fmaxf(mq, __shfl_xor(mq, o)); mk = __builtin_fmaxf(mk, __shfl_xor(mk, o)); }
            dil_fixed = (8.f * 1.4426950408889634f * 1.02f) * mq * mk < 100.f;
        }
        LAS unsigned char* wl = lds + 32768 + wave * DIL_WL;
#define RUN_DIL(FX) do { for (int rep = 0; rep < REP_DIL; ++rep) { const int NW = G * NWAVES, gw = vcu * NWAVES + wave; \
            _Pragma("unroll 1") for (int t = gw; t < 64 * 384 / 2; t += NW) { int pr = t;     \
                if (G == 256) { const int x = gw >> 8, lw = gw & 255, k = t / NW; pr = x * 1536 + ((lw + 37 * k) & 255) + 256 * k; }     \
                dil_pair<FX>(pr, QKV, (bf16*)(ws + WS_DILO), (float*)(ws + WS_LSE), wl, lane); } } } while (0)
        if (dil_fixed) RUN_DIL(true); else RUN_DIL(false);
#undef RUN_DIL
    }
    SEAM(3);
    if (IN(4)) { for (int rep = 0; rep < REP_P2C; ++rep) p2c_merge_norm(args, vcu, G, wave, lane); }
    SEAM(4);
    if (IN(5)) {
        for (int rep = 0; rep < REP_P3; ++rep) {
        pg8::Gemm g{(const pg8::bf16_t*)(ws + WS_MIXN), (const pg8::bf16_t*)(ws + WS_WOUT), TOK, DM, DM}; pg8::StaticOrder S; S.init(TOK, DM, G, bx);
        pg8::EpiRes1 E{args.x, (pg8::bf16_t*)(ws + WS_XN), (float*)(ws + WS_SSQ), DM};
        pg8::gemm_phase<pg8::EpiRes1, pg8::StaticOrder, true, true>(lds, g, S, E);
        }
    }
    SEAM(5);
    if (IN(6)) {
        for (int rep = 0; rep < REP_P4; ++rep) {
        pg8::Gemm g{(const pg8::bf16_t*)(ws + WS_XN), (const pg8::bf16_t*)(ws + WS_WGU), TOK, 2 * DFF, DM}; pg8::StaticOrder S; S.init(TOK, 2 * DFF, G, bx);
        pg8::EpiSwiGLU E{(pg8::bf16_t*)(ws + WS_ACT), DFF, (const float*)(ws + WS_SSQ), 1.f / DM, EPS};
        pg8::gemm_phase<pg8::EpiSwiGLU, pg8::StaticOrder, true, true>(lds, g, S, E);
        }
    }
    SEAM(6);
    if (IN(7)) {
        for (int rep = REP_P5 - 1; rep >= 0; --rep) {
        pg8::Gemm g{(const pg8::bf16_t*)(ws + WS_ACT), (const pg8::bf16_t*)(ws + WS_WD), TOK, DM, DFF}; pg8::StaticOrder S; S.init(TOK, DM, G, bx);
        pg8::EpiRes2 E{(const pg8::bf16_t*)(ws + WS_XN), rep ? (float*)(ws + WS_MIX) : args.out, DM};
        pg8::gemm_phase<pg8::EpiRes2, pg8::StaticOrder, true, true>(lds, g, S, E);
        }
    }
#undef IN
#undef SEAM
}

extern "C" void kernel_launch(void* const* d_in, const int* in_sizes, int n_in, void* d_out, int out_size, void* d_ws, size_t ws_size, hipStream_t stream) {
    static int grid = 0;
    if (grid == 0) {
        if (n_in != 12 || in_sizes[0] != TOK * DM || out_size != TOK * DM || ws_size < WS_END) { fprintf(stderr, "kernel_launch: unexpected shapes / workspace (n_in %d, in0 %d, out %d, ws %zu)\n", n_in, n_in > 0 ? in_sizes[0] : -1, out_size, ws_size); grid = -1; return; }
        int dev = 0, cus = 0, per_cu = 0;
        if (hipGetDevice(&dev) != hipSuccess || hipDeviceGetAttribute(&cus, hipDeviceAttributeMultiprocessorCount, dev) != hipSuccess) { grid = -1; return; }
        if (hipFuncSetAttribute((const void*)hymba_fwd, hipFuncAttributeMaxDynamicSharedMemorySize, LDS_BYTES) != hipSuccess) { fprintf(stderr, "kernel_launch: hipFuncSetAttribute failed\n"); grid = -1; return; }
        if (hipOccupancyMaxActiveBlocksPerMultiprocessor(&per_cu, (const void*)hymba_fwd, NWAVES * 64, LDS_BYTES) != hipSuccess || per_cu < 1) { fprintf(stderr, "kernel_launch: occupancy query says %d blocks per CU\n", per_cu); per_cu = 1; }
        (void)hipGetLastError();
        grid = cus;
    }
    if (grid < 0) return;
    if (hipMemsetAsync((char*)d_ws + WS_CTL, 0, 65536, stream) != hipSuccess) { fprintf(stderr, "kernel_launch: hipMemsetAsync failed\n"); return; }
    Args a{};
    a.x = (const float*)d_in[0]; a.attn_norm_w = (const float*)d_in[1]; a.w_in = (const float*)d_in[2]; a.q_norm_w = (const float*)d_in[3]; a.k_norm_w = (const float*)d_in[4];
    a.dil_norm_w = (const float*)d_in[5]; a.sb_norm_w = (const float*)d_in[6]; a.w_out = (const float*)d_in[7]; a.ffn_norm_w = (const float*)d_in[8];
    a.w_gate = (const float*)d_in[9]; a.w_up = (const float*)d_in[10]; a.w_down = (const float*)d_in[11];
    a.out = (float*)d_out; a.ws = (unsigned char*)d_ws; a.ph_lo = 0; a.ph_hi = 8;
    void* kargs[] = {&a};
    const hipError_t le = hipLaunchCooperativeKernel((const void*)hymba_fwd, dim3(grid), dim3(NWAVES * 64), kargs, LDS_BYTES, stream);
    if (le != hipSuccess) fprintf(stderr, "kernel_launch: cooperative launch failed: %s (grid %d)\n", hipGetErrorName(le), grid);
}
```

```cpp
#include <hip/hip_runtime.h>
#include <hip/hip_cooperative_groups.h>
#include <cstdio>
#include <cstdint>
#include <cmath>
namespace cg = cooperative_groups;
namespace pg8 {
#define PG8_LAS __attribute__((address_space(3)))
typedef unsigned short bf16_t;
typedef short bf16x8 __attribute__((ext_vector_type(8)));
typedef float f32x4 __attribute__((ext_vector_type(4)));
typedef unsigned u32x4 __attribute__((ext_vector_type(4)));
constexpr int BM = 256, BK = 64, HALF = 128, HTB = HALF * BK * 2  , STAGE_BYTES = 8 * HTB, NXCD = 8, WGM = 2  ;

__host__ __device__ __forceinline__ int lds_byte(int r, int c) { const int st = (r >> 4) * 2 + (c >> 5), rr = r & 15, cc = c & 31, ob = rr * 64 + cc * 2; return st * 1024 + (ob ^ (((ob >> 9) & 1) << 5)); }
__host__ __device__ __forceinline__ void stage_rc(int b, int& R, int& C) { const int st = b / 1024, sb = b % 1024, swz = sb ^ (((sb >> 9) & 1) << 5); R = (st >> 1) * 16 + swz / 64; C = (st & 1) * 32 + (swz % 64) / 2; }
__host__ __device__ __forceinline__ int perm32(int rho) { const int n = rho >> 4, i = rho & 15; return 8 * (i >> 2) + 4 * n + (i & 3); }

struct Unit { int pm, pn; };
struct Gemm { const bf16_t* A; const bf16_t* Bt; int M, N, K; };

struct StaticOrder {
    int nM, nN, nwg, G, c;
    __host__ __device__ void init(int M, int N, int G_, int c_) { nM = M / BM; nN = N / BM; nwg = nM * nN; G = G_; c = c_; }
    __host__ __device__ bool next(int i, Unit& u) const {
        const long L = (long)i * G + c; if (L >= nwg) return false;
        int wgid = (int)L; { const int q = nwg / NXCD, r = nwg % NXCD, xcd = wgid % NXCD, off = wgid / NXCD; wgid = (xcd < r ? xcd * (q + 1) : r * (q + 1) + (xcd - r) * q) + off; }
        const int nig = WGM * nN, gid = wgid / nig, fm = gid * WGM, gsz = (nM - fm) < WGM ? (nM - fm) : WGM;
        u.pm = fm + ((wgid % nig) % gsz); u.pn = (wgid % nig) / gsz; return true;
    }
    __device__ __forceinline__ void a_ready(const Unit&) const {}
    __device__ __forceinline__ void done(const Unit&) const {}
};

__device__ __forceinline__ unsigned cvt_pk_bf16(float lo, float hi) { unsigned r; asm volatile("v_cvt_pk_bf16_f32 %0, %1, %2" : "=v"(r) : "v"(lo), "v"(hi)); return r; }
typedef float f32x2 __attribute__((ext_vector_type(2)));
struct EpiQKV {
    static constexpr bool PERM = true, AFTER_DRAIN = false;
    static constexpr int M_TOK = 32768;
    bf16_t* O; int ldc; int n_q, n_norm, qs_lo, qs_hi; float scale; const float* qw; const float* kw; const float* ct; const float* st; float eps;
    __device__ __forceinline__ void operator()(const f32x4 (&acc)[2][2][4][2], const Unit& u, int wr, int wc, int fr, int fq) const {
        const int row0 = u.pm * BM + wr * 64 + fr; bf16_t* const Oh = O + (size_t)(u.pn >> 1) * ((size_t)M_TOK * 512) + (size_t)(4 * (u.pn & 1) + wc) * (4096 * 64) + 8 * fq;
        if (u.pn < n_norm) {
            const bool isq = u.pn < n_q; const float* w = isq ? qw : kw; const float osc = isq ? scale : 1.f;
            const f32x4 wl0 = *(const f32x4*)(w + 8 * fq), wl1 = *(const f32x4*)(w + 8 * fq + 4), wh0 = *(const f32x4*)(w + 32 + 8 * fq), wh1 = *(const f32x4*)(w + 32 + 8 * fq + 4);
#pragma unroll
            for (int ab = 0; ab < 4; ++ab) { const int ai = ab >> 1, mb = (ab & 1) * 2;
                f32x4 tc0[4], tc1[4], ts0[4], ts1[4];
#pragma unroll
                for (int m = mb; m < mb + 2; ++m) { const int pos = (row0 + ai * HALF + m * 16) & 4095;
                    tc0[m] = *(const f32x4*)(ct + pos * 32 + 8 * fq); tc1[m] = *(const f32x4*)(ct + pos * 32 + 8 * fq + 4); ts0[m] = *(const f32x4*)(st + pos * 32 + 8 * fq); ts1[m] = *(const f32x4*)(st + pos * 32 + 8 * fq + 4); }
#pragma unroll
                for (int m = mb; m < mb + 2; ++m) { const int r = row0 + ai * HALF + m * 16; const int pos = r & 4095;
                    const f32x4 c0 = tc0[m], c1 = tc1[m], s0 = ts0[m], s1 = ts1[m];
                    const f32x4 a0 = acc[ai][0][m][0], a1 = acc[ai][0][m][1], b0 = acc[ai][1][m][0], b1 = acc[ai][1][m][1];
                    const f32x4 q2 = (a0 * a0 + a1 * a1) + (b0 * b0 + b1 * b1); float ss = (q2[0] + q2[1]) + (q2[2] + q2[3]);
                    ss += __shfl_xor(ss, 16); ss += __shfl_xor(ss, 32);
                    const float rs = __builtin_amdgcn_rsqf(ss * (1.f / 64.f) + eps) * osc;
                    const f32x4 yl0 = a0 * rs * wl0, yl1 = a1 * rs * wl1, yh0 = b0 * rs * wh0, yh1 = b1 * rs * wh1;
                    const f32x4 ol0 = yl0 * c0 - yh0 * s0, ol1 = yl1 * c1 - yh1 * s1, oh0 = yh0 * c0 + yl0 * s0, oh1 = yh1 * c1 + yl1 * s1;
                    bf16_t* rowp = Oh + ((size_t)(r >> 12) * (8 * 4096) + (size_t)pos) * 64;
                    u32x4 wv; wv.x = cvt_pk_bf16(ol0[0], ol0[1]); wv.y = cvt_pk_bf16(ol0[2], ol0[3]); wv.z = cvt_pk_bf16(ol1[0], ol1[1]); wv.w = cvt_pk_bf16(ol1[2], ol1[3]); *(u32x4*)rowp = wv;
                    wv.x = cvt_pk_bf16(oh0[0], oh0[1]); wv.y = cvt_pk_bf16(oh0[2], oh0[3]); wv.z = cvt_pk_bf16(oh1[0], oh1[1]); wv.w = cvt_pk_bf16(oh1[2], oh1[3]); *(u32x4*)(rowp + 32) = wv; }
            }
        } else {
            const float sc = (u.pn >= qs_lo && u.pn <= qs_hi) ? scale : 1.f;
#pragma unroll
            for (int ai = 0; ai < 2; ++ai)
#pragma unroll
                for (int m = 0; m < 4; ++m) { const int r = row0 + ai * HALF + m * 16; bf16_t* rowp = Oh + ((size_t)(r >> 12) * (8 * 4096) + (size_t)(r & 4095)) * 64;
#pragma unroll
                    for (int bj = 0; bj < 2; ++bj) { const f32x4 v0 = acc[ai][bj][m][0] * sc, v1 = acc[ai][bj][m][1] * sc;
                        u32x4 w; w.x = cvt_pk_bf16(v0[0], v0[1]); w.y = cvt_pk_bf16(v0[2], v0[3]); w.z = cvt_pk_bf16(v1[0], v1[1]); w.w = cvt_pk_bf16(v1[2], v1[3]);
                        *(u32x4*)(rowp + bj * 32) = w; } }
        }
    }
};
struct EpiRes1 {
    static constexpr bool PERM = true, AFTER_DRAIN = false;
    const float* base; bf16_t* xn; float* ssq; int ldc;
    __device__ __forceinline__ void operator()(const f32x4 (&acc)[2][2][4][2], const Unit& u, int wr, int wc, int fr, int fq) const {
        const int col0 = u.pn * BM + wc * 32 + 8 * fq;
#pragma unroll
        for (int ab = 0; ab < 4; ++ab) { const int ai = ab >> 1, mb = (ab & 1) * 2;
            f32x4 bx[4][2][2];
#pragma unroll
            for (int m = mb; m < mb + 2; ++m) { const size_t off = (size_t)(u.pm * BM + ai * HALF + wr * 64 + m * 16 + fr) * ldc + col0;
#pragma unroll
                for (int bj = 0; bj < 2; ++bj) { bx[m][bj][0] = __builtin_nontemporal_load((const f32x4*)(base + off + bj * HALF)); bx[m][bj][1] = __builtin_nontemporal_load((const f32x4*)(base + off + bj * HALF + 4)); } }
#pragma unroll
            for (int m = mb; m < mb + 2; ++m) { const int r = u.pm * BM + ai * HALF + wr * 64 + m * 16 + fr; const size_t off = (size_t)r * ldc + col0; float ss = 0.f;
#pragma unroll
                for (int bj = 0; bj < 2; ++bj) { const f32x4 v0 = bx[m][bj][0] + acc[ai][bj][m][0], v1 = bx[m][bj][1] + acc[ai][bj][m][1];
                    u32x4 w; w.x = cvt_pk_bf16(v0[0], v0[1]); w.y = cvt_pk_bf16(v0[2], v0[3]); w.z = cvt_pk_bf16(v1[0], v1[1]); w.w = cvt_pk_bf16(v1[2], v1[3]); *(u32x4*)(xn + off + bj * HALF) = w;
                    ss += ((v0[0] * v0[0] + v0[1] * v0[1]) + (v0[2] * v0[2] + v0[3] * v0[3])) + ((v1[0] * v1[0] + v1[1] * v1[1]) + (v1[2] * v1[2] + v1[3] * v1[3])); }
                ss += __shfl_xor(ss, 16); ss += __shfl_xor(ss, 32);
                if (fq == 0) ssq[(size_t)r * 16 + u.pn * 4 + wc] = ss; }
        }
    }
};
struct EpiSwiGLU {
    static constexpr bool PERM = true, AFTER_DRAIN = false;
    bf16_t* O; int ldc; const float* ssq; float inv_d, eps;
    __device__ __forceinline__ void operator()(const f32x4 (&acc)[2][2][4][2], const Unit& u, int wr, int wc, int fr, int fq) const {
        const int row0 = u.pm * BM + wr * 64 + fr, col0 = u.pn * HALF + wc * 32 + 8 * fq;
        f32x4 sq[2][4];
#pragma unroll
        for (int ai = 0; ai < 2; ++ai)
#pragma unroll
            for (int m = 0; m < 4; ++m) sq[ai][m] = *(const f32x4*)(ssq + (size_t)(row0 + ai * HALF + m * 16) * 16 + 4 * fq);
#pragma unroll
        for (int ai = 0; ai < 2; ++ai)
#pragma unroll
            for (int m = 0; m < 4; ++m) { const int r = row0 + ai * HALF + m * 16;
                float t = (sq[ai][m][0] + sq[ai][m][1]) + (sq[ai][m][2] + sq[ai][m][3]); t += __shfl_xor(t, 16); t += __shfl_xor(t, 32);
                const float rs = __builtin_amdgcn_rsqf(t * inv_d + eps);
                float a[8];
#pragma unroll
                for (int n = 0; n < 2; ++n)
#pragma unroll
                    for (int i = 0; i < 4; ++i) { const float g = acc[ai][0][m][n][i] * rs, uu = acc[ai][1][m][n][i] * rs;
                        a[n * 4 + i] = g * __builtin_amdgcn_rcpf(1.f + __builtin_amdgcn_exp2f(-1.4426950408889634f * g)) * uu; }
                u32x4 w; w.x = cvt_pk_bf16(a[0], a[1]); w.y = cvt_pk_bf16(a[2], a[3]); w.z = cvt_pk_bf16(a[4], a[5]); w.w = cvt_pk_bf16(a[6], a[7]);
                *(u32x4*)(O + (size_t)r * ldc + col0) = w; }
    }
};
struct EpiRes2 {
    static constexpr bool PERM = true, AFTER_DRAIN = false;
    const bf16_t* xn; float* out; int ldc;
    __device__ __forceinline__ void operator()(const f32x4 (&acc)[2][2][4][2], const Unit& u, int wr, int wc, int fr, int fq) const {
        const int col0 = u.pn * BM + wc * 32 + 8 * fq;
#pragma unroll
        for (int ai = 0; ai < 2; ++ai) {
            u32x4 xv[4][2];
#pragma unroll
            for (int m = 0; m < 4; ++m) { const size_t off = (size_t)(u.pm * BM + ai * HALF + wr * 64 + m * 16 + fr) * ldc + col0;
                xv[m][0] = *(const u32x4*)(xn + off); xv[m][1] = *(const u32x4*)(xn + off + HALF); }
#pragma unroll
            for (int m = 0; m < 4; ++m) { const size_t off = (size_t)(u.pm * BM + ai * HALF + wr * 64 + m * 16 + fr) * ldc + col0;
#pragma unroll
                for (int bj = 0; bj < 2; ++bj) { const u32x4 w = xv[m][bj];
                    f32x4 b0, b1; b0[0] = __builtin_bit_cast(float, w.x << 16); b0[1] = __builtin_bit_cast(float, w.x & 0xffff0000u); b0[2] = __builtin_bit_cast(float, w.y << 16); b0[3] = __builtin_bit_cast(float, w.y & 0xffff0000u);
                    b1[0] = __builtin_bit_cast(float, w.z << 16); b1[1] = __builtin_bit_cast(float, w.z & 0xffff0000u); b1[2] = __builtin_bit_cast(float, w.w << 16); b1[3] = __builtin_bit_cast(float, w.w & 0xffff0000u);
                    *(f32x4*)(out + off + bj * HALF) = b0 + acc[ai][bj][m][0]; *(f32x4*)(out + off + bj * HALF + 4) = b1 + acc[ai][bj][m][1]; } }
        }
    }
};
template <class Epi, class Sched, bool ALIGN_EPI = false, bool SP2 = false>
__device__ __forceinline__ void gemm_phase(PG8_LAS unsigned char* lds, const Gemm g, const Sched& S, const Epi& E) {
    const int tid = threadIdx.x, wid = __builtin_amdgcn_readfirstlane(tid >> 6), lane = tid & 63, wr = wid >> 2, wc = wid & 3, fr = lane & 15, fq = lane >> 4;
    const int K = g.K, nt = K / BK;
    unsigned voffA[2], voffB[2];
#pragma unroll
    for (int i = 0; i < 2; ++i) { int R, C; stage_rc(tid * 16 + i * 8192, R, C); const int Rb = Epi::PERM ? ((R & ~31) + perm32(R & 31)) : R;
        voffA[i] = (unsigned)(R * K + C) * 2u; voffB[i] = (unsigned)(Rb * K + C) * 2u; }
    const size_t kstep = (size_t)(BK * 2);
    const size_t hstep = (size_t)HALF * K * 2;
    const size_t tstep = 2 * hstep;
    const unsigned ldsw = (unsigned)wid * 1024u;
    const int aoff = lds_byte(wr * 64 + fr, fq * 8), boff = lds_byte(wc * 32 + fr, fq * 8);
#define PG8_SA(b, h) (((b) * 2 + (h)) * HTB)
#define PG8_SB(b, h) ((4 + (b) * 2 + (h)) * HTB)
#define PG8_STAGE(bufoff, gbase, voff) do { _Pragma("unroll") for (int _i = 0; _i < 2; ++_i) \
        __builtin_amdgcn_global_load_lds((const unsigned*)((const char*)(gbase) + (voff)[_i]), (PG8_LAS unsigned*)(lds + (bufoff) + ldsw + _i * 8192), 16, 0, 0); } while (0)
#define PG8_LDA(dst, b, h) do { _Pragma("unroll") for (int m = 0; m < 4; ++m) _Pragma("unroll") for (int k = 0; k < 2; ++k) dst[m][k] = *(const PG8_LAS bf16x8*)(lds + PG8_SA(b, h) + aoff + m * 2048 + k * 1024); } while (0)
#define PG8_LDB(dst, b, h) do { _Pragma("unroll") for (int n = 0; n < 2; ++n) _Pragma("unroll") for (int k = 0; k < 2; ++k) dst[n][k] = *(const PG8_LAS bf16x8*)(lds + PG8_SB(b, h) + boff + n * 2048 + k * 1024); } while (0)
#define PG8_MMA(ai, bj, At, Bt) do { __builtin_amdgcn_s_setprio(1); _Pragma("unroll") for (int m = 0; m < 4; ++m) _Pragma("unroll") for (int n = 0; n < 2; ++n) _Pragma("unroll") for (int k = 0; k < 2; ++k) \
        acc[ai][bj][m][n] = __builtin_amdgcn_mfma_f32_16x16x32_bf16(Bt[n][k], At[m][k], acc[ai][bj][m][n], 0, 0, 0); __builtin_amdgcn_s_setprio(0); } while (0)
#define PG8_WAIT_V(n) asm volatile("s_waitcnt vmcnt(" #n ")" ::: "memory")
#define PG8_WAIT_L(n) asm volatile("s_waitcnt lgkmcnt(" #n ")" ::: "memory")
#define PG8_BAR __builtin_amdgcn_s_barrier()
#define PG8_SCHED __builtin_amdgcn_sched_barrier(0)
    Unit cur, nxt; int ui = 0;
    if (!S.next(0, cur)) return;
    f32x4 acc[2][2][4][2];
#pragma unroll
    for (int a = 0; a < 2; ++a)
#pragma unroll
        for (int b = 0; b < 2; ++b)
#pragma unroll
            for (int m = 0; m < 4; ++m)
#pragma unroll
                for (int n = 0; n < 2; ++n) acc[a][b][m][n] = (f32x4){0.f, 0.f, 0.f, 0.f};
    bf16x8 At[4][2], B0[2][2], B1[2][2];
    const char* cA = (const char*)g.A + (size_t)cur.pm * tstep; const char* cB = (const char*)g.Bt + (size_t)cur.pn * tstep;
    S.a_ready(cur);
    if constexpr (SP2) {
        PG8_STAGE(PG8_SB(0, 0), cB, voffB); PG8_STAGE(PG8_SB(0, 1), cB + hstep, voffB); PG8_STAGE(PG8_SA(0, 0), cA, voffA); PG8_STAGE(PG8_SA(0, 1), cA + hstep, voffA);
        if (wr == 1) PG8_BAR;
        PG8_WAIT_V(2); PG8_BAR;
        PG8_STAGE(PG8_SB(1, 0), cB + kstep, voffB); PG8_STAGE(PG8_SA(1, 0), cA + kstep, voffA); PG8_STAGE(PG8_SB(1, 1), cB + hstep + kstep, voffB);
        PG8_WAIT_V(6); PG8_BAR;
    } else {
        PG8_STAGE(PG8_SB(0, 0), cB, voffB); PG8_STAGE(PG8_SA(0, 0), cA, voffA); PG8_STAGE(PG8_SB(0, 1), cB + hstep, voffB); PG8_STAGE(PG8_SA(0, 1), cA + hstep, voffA);
        if (wr == 1) PG8_BAR;
        PG8_WAIT_V(4); PG8_BAR;
        PG8_STAGE(PG8_SB(1, 0), cB + kstep, voffB); PG8_STAGE(PG8_SA(1, 0), cA + kstep, voffA); PG8_STAGE(PG8_SB(1, 1), cB + hstep + kstep, voffB);
        PG8_WAIT_V(6); PG8_BAR;
    }
    for (;;) {
        const bool has_next = S.next(ui + 1, nxt);
        const char* nA = has_next ? (const char*)g.A + (size_t)nxt.pm * tstep : cA; const char* nB = has_next ? (const char*)g.Bt + (size_t)nxt.pn * tstep : cB;
        for (int t = 0; t < nt; t += 2) {
            const bool last = (t == nt - 2);
            const char* a1 = cA + (size_t)(t + 1) * kstep;
            const char* a2 = last ? nA : cA + (size_t)(t + 2) * kstep; const char* b2 = last ? nB : cB + (size_t)(t + 2) * kstep;
            const char* a3 = a2 + kstep; const char* b3 = b2 + kstep;
            if (last && has_next) S.a_ready(nxt);
            if constexpr (SP2) {
            PG8_LDB(B0, 0, 0); PG8_LDB(B1, 0, 1); PG8_SCHED; PG8_LDA(At, 0, 0); PG8_STAGE(PG8_SA(1, 1), a1 + hstep, voffA);
            PG8_WAIT_V(8); PG8_WAIT_L(0); PG8_BAR; PG8_MMA(0, 0, At, B0); PG8_MMA(0, 1, At, B1); PG8_BAR; PG8_SCHED;
            PG8_LDA(At, 0, 1); PG8_STAGE(PG8_SB(0, 0), b2, voffB); PG8_STAGE(PG8_SB(0, 1), b2 + hstep, voffB); PG8_STAGE(PG8_SA(0, 0), a2, voffA);
            PG8_WAIT_V(8); PG8_WAIT_L(0); PG8_BAR; PG8_MMA(1, 0, At, B0); PG8_MMA(1, 1, At, B1); PG8_BAR; PG8_SCHED;
            PG8_LDB(B0, 1, 0); PG8_LDB(B1, 1, 1); PG8_SCHED; PG8_LDA(At, 1, 0); PG8_STAGE(PG8_SA(0, 1), a2 + hstep, voffA);
            PG8_WAIT_V(8); PG8_WAIT_L(0); PG8_BAR; PG8_MMA(0, 0, At, B0); PG8_MMA(0, 1, At, B1); PG8_BAR; PG8_SCHED;
            PG8_LDA(At, 1, 1); PG8_STAGE(PG8_SB(1, 0), b3, voffB); PG8_STAGE(PG8_SB(1, 1), b3 + hstep, voffB); PG8_STAGE(PG8_SA(1, 0), a3, voffA);
            PG8_WAIT_V(8); PG8_WAIT_L(0); PG8_BAR; PG8_MMA(1, 0, At, B0); PG8_MMA(1, 1, At, B1); PG8_BAR; PG8_SCHED;
            } else {
            PG8_LDB(B0, 0, 0); PG8_SCHED; PG8_LDA(At, 0, 0); PG8_STAGE(PG8_SA(1, 1), a1 + hstep, voffA);
            PG8_WAIT_L(8); PG8_BAR; PG8_WAIT_L(0); PG8_MMA(0, 0, At, B0); PG8_BAR; PG8_SCHED;
            PG8_LDB(B1, 0, 1); PG8_STAGE(PG8_SB(0, 0), b2, voffB);
            PG8_BAR; PG8_WAIT_L(0); PG8_MMA(0, 1, At, B1); PG8_BAR;
            PG8_LDA(At, 0, 1); PG8_STAGE(PG8_SA(0, 0), a2, voffA);
            PG8_BAR; PG8_WAIT_L(0); PG8_MMA(1, 0, At, B0); PG8_BAR; PG8_SCHED;
            PG8_STAGE(PG8_SB(0, 1), b2 + hstep, voffB);
            PG8_WAIT_V(6); PG8_BAR; PG8_MMA(1, 1, At, B1); PG8_BAR;
            PG8_LDB(B0, 1, 0); PG8_SCHED; PG8_LDA(At, 1, 0); PG8_STAGE(PG8_SA(0, 1), a2 + hstep, voffA);
            PG8_WAIT_L(8); PG8_BAR; PG8_WAIT_L(0); PG8_MMA(0, 0, At, B0); PG8_BAR; PG8_SCHED;
            PG8_LDB(B1, 1, 1); PG8_STAGE(PG8_SB(1, 0), b3, voffB);
            PG8_BAR; PG8_WAIT_L(0); PG8_MMA(0, 1, At, B1); PG8_BAR;
            PG8_LDA(At, 1, 1); PG8_STAGE(PG8_SA(1, 0), a3, voffA);
            PG8_BAR; PG8_WAIT_L(0); PG8_MMA(1, 0, At, B0); PG8_BAR; PG8_SCHED;
            PG8_STAGE(PG8_SB(1, 1), b3 + hstep, voffB);
            PG8_WAIT_V(6); PG8_BAR; PG8_MMA(1, 1, At, B1); PG8_BAR;
            }
        }
        if constexpr (ALIGN_EPI) { if (wr == 0) PG8_BAR; }
        if constexpr (!Epi::AFTER_DRAIN) { E(acc, cur, wr, wc, fr, fq); S.done(cur); }
        if (!has_next) break;
#pragma unroll
        for (int a = 0; a < 2; ++a)
#pragma unroll
            for (int b = 0; b < 2; ++b)
#pragma unroll
                for (int m = 0; m < 4; ++m)
#pragma unroll
                    for (int n = 0; n < 2; ++n) acc[a][b][m][n] = (f32x4){0.f, 0.f, 0.f, 0.f};
        cur = nxt; cA = nA; cB = nB; ++ui;
        if constexpr (ALIGN_EPI) { if (wr == 1) PG8_BAR; }
    }
    PG8_WAIT_V(0);
    if constexpr (!ALIGN_EPI) { if (wr == 0) PG8_BAR; }
    PG8_BAR;
    if constexpr (Epi::AFTER_DRAIN) { E.fused(acc, cur, wr, wc, fr, fq, lds, wid, lane); S.done(cur); }
#undef PG8_SA
#undef PG8_SB
#undef PG8_STAGE
#undef PG8_LDA
#undef PG8_LDB
#undef PG8_MMA
#undef PG8_WAIT_V
#undef PG8_WAIT_L
#undef PG8_BAR
#undef PG8_SCHED
}
}

constexpr int BATCH = 8, SEQ = 4096, DM = 1024, TOK = BATCH * SEQ, DIN = 3072, DFF = 2816, NH = 8, HD = 64;
constexpr float EPS = 1e-6f;
constexpr float QSCALE = 0.125f * 1.4426950408889634f;
constexpr int C_QA = 0, C_KA = 512, C_VA = 1024, C_QS = 1536, C_KS = 2048, C_VS = 2560;
constexpr size_t SLAB = (size_t)TOK * 512;

constexpr size_t MiB = 1u << 20;
constexpr size_t WS_CTL = 0;
constexpr size_t WS_WIN = 1 * MiB, WS_WOUT = 7 * MiB, WS_WGU = 9 * MiB, WS_WD = 20 * MiB;
constexpr size_t WS_ROPE = 26 * MiB;
constexpr size_t WS_SSQ = 27 * MiB;
constexpr size_t WS_LSE = 29 * MiB;
constexpr size_t WS_XN = 32 * MiB;
constexpr size_t WS_QKV = 96 * MiB;
constexpr size_t WS_ACT = 96 * MiB;
constexpr size_t WS_MIX = 288 * MiB;
constexpr size_t WS_MIXN = 96 * MiB;
constexpr size_t WS_DILO = 352 * MiB;
constexpr size_t WS_END = 448 * MiB;

constexpr int NWAVES = 8;
constexpr int RING_BYTES = 131072;
constexpr int LDS_BYTES = 147456;

#define LAS __attribute__((address_space(3)))
typedef unsigned short bf16;
__device__ __forceinline__ const bf16* head_base(const bf16* QKV, int slab, int b, int h) { return QKV + (size_t)slab * SLAB + (size_t)(b * NH + h) * (SEQ * HD); }
typedef float f32x4 __attribute__((ext_vector_type(4)));
typedef float f32x16 __attribute__((ext_vector_type(16)));
typedef short bf16x8 __attribute__((ext_vector_type(8)));
typedef short s16x4 __attribute__((ext_vector_type(4)));
typedef _Float16 f16x8 __attribute__((ext_vector_type(8)));
typedef unsigned u32x4 __attribute__((ext_vector_type(4)));
typedef unsigned u32x2 __attribute__((ext_vector_type(2)));

__device__ __forceinline__ unsigned f2bf(float f) { unsigned u = __builtin_bit_cast(unsigned, f); return (u + 0x7fffu + ((u >> 16) & 1u)) >> 16; }
__device__ __forceinline__ unsigned pk2(float lo, float hi) { return pg8::cvt_pk_bf16(lo, hi); }
__device__ __forceinline__ float bf_lo(unsigned w) { return __builtin_bit_cast(float, w << 16); }
__device__ __forceinline__ float bf_hi(unsigned w) { return __builtin_bit_cast(float, w & 0xffff0000u); }
__device__ __forceinline__ int crow(int r, int hi) { return (r & 3) + 8 * (r >> 2) + 4 * hi; }
__device__ __forceinline__ s16x4 vtr(LAS const unsigned char* p) { return __builtin_bit_cast(s16x4, __builtin_amdgcn_ds_read_tr16_b64_v4i16((LAS s16x4*)p)); }
#define MFMA_BF16(a, b, c) __builtin_amdgcn_mfma_f32_32x32x16_bf16((a), (b), (c), 0, 0, 0)
#define MFMA_F16(a, b, c) __builtin_amdgcn_mfma_f32_32x32x16_f16((a), (b), (c), 0, 0, 0)

struct Args {
    const float* x; const float* attn_norm_w; const float* w_in; const float* q_norm_w; const float* k_norm_w; const float* dil_norm_w; const float* sb_norm_w;
    const float* w_out; const float* ffn_norm_w; const float* w_gate; const float* w_up; const float* w_down;
    float* out; unsigned char* ws; int ph_lo, ph_hi;
};
#define XB_TMO      128
#define XB_XCNT(j)  (256  + 64 * (j))
#define XB_XSUB(j)  (1280 + 64 * (j))
#define XB_XGEN(j)  (2304 + 64 * (j))
#define XB_TOP      3328
#define XB_TOPGEN   3392
#define XCD_BAR_WORDS 3456
#define XB_SPIN_CAP (1u << 18)

__device__ __forceinline__ unsigned xb_ld(unsigned* p)              { return __hip_atomic_load(p, __ATOMIC_RELAXED, __HIP_MEMORY_SCOPE_AGENT); }
__device__ __forceinline__ unsigned xb_add(unsigned* p, unsigned v) { return __hip_atomic_fetch_add(p, v, __ATOMIC_RELAXED, __HIP_MEMORY_SCOPE_AGENT); }
__device__ __forceinline__ unsigned xb_xcc_id() { return (unsigned)__builtin_amdgcn_s_getreg((3 << 11) | 20) & 0xFu; }
#define XB_SPIN(cond, bar) do { unsigned _sp = 0; while (cond) { __builtin_amdgcn_s_sleep(1); \
    if ((++_sp & 255u) == 0u) { if (xb_ld(&(bar)[XB_TMO])) break; if (_sp > XB_SPIN_CAP) { atomicAdd(&(bar)[XB_TMO], 1u); break; } } } } while (0)

struct XcdBarrier {
    unsigned* bar; unsigned x;
    volatile LAS unsigned* st;
};

__device__ __forceinline__ XcdBarrier xcd_barrier_post(unsigned* bar, volatile LAS unsigned* st) {
    XcdBarrier b; b.bar = bar; b.x = xb_xcc_id(); b.st = st;
    if (threadIdx.x == 0) (void)xb_add(&bar[XB_XCNT(b.x)], 1u);
    return b;
}
__device__ __forceinline__ void xcd_barrier_complete(unsigned* bar, unsigned x, unsigned& nloc, unsigned& nx) {
    const unsigned G = gridDim.x * gridDim.y * gridDim.z;
    unsigned sum, cnt, mine, sp = 0u;
    for (;;) {
        sum = 0u; cnt = 0u; mine = 0u;
#pragma unroll
        for (unsigned j = 0; j < 16; ++j) { const unsigned c = xb_ld(&bar[XB_XCNT(j)]); sum += c; cnt += (c > 0u) ? 1u : 0u; mine = (j == x) ? c : mine; }
        if (sum == G) break;
        __builtin_amdgcn_s_sleep(1);
        if ((++sp & 255u) == 0u) { if (xb_ld(&bar[XB_TMO])) break; if (sp > XB_SPIN_CAP) { atomicAdd(&bar[XB_TMO], 1u); break; } }
    }
    nloc = mine > 0u ? mine : 1u; nx = cnt > 0u ? cnt : 1u;
}

__device__ __forceinline__ void xcd_barrier(const XcdBarrier& b) {
    asm volatile("s_waitcnt vmcnt(0)" ::: "memory");
    __syncthreads();
    if (threadIdx.x == 0) {
        unsigned* bar = b.bar;
        __builtin_amdgcn_s_waitcnt(0);
        unsigned nloc = b.st[0], nx = b.st[1];
        if (nloc == 0u) { xcd_barrier_complete(bar, b.x, nloc, nx); b.st[0] = nloc; b.st[1] = nx; }
        const unsigned old = xb_add(&bar[XB_XSUB(b.x)], 1u);
        const unsigned gen = old / nloc;
        if (old + 1u == (gen + 1u) * nloc) {
            __builtin_amdgcn_fence(__ATOMIC_RELEASE, "agent");
            asm volatile("s_waitcnt vmcnt(0)" ::: "memory");
            const unsigned og = xb_add(&bar[XB_TOP], 1u);
            const unsigned tg = og / nx;
            if (og + 1u == (tg + 1u) * nx) xb_add(&bar[XB_TOPGEN], 1u);
            else XB_SPIN(xb_ld(&bar[XB_TOPGEN]) == tg, bar);
            __builtin_amdgcn_fence(__ATOMIC_ACQUIRE, "agent");
            xb_add(&bar[XB_XGEN(b.x)], 1u);
            asm volatile("s_waitcnt vmcnt(0)" ::: "memory");
        } else {
            XB_SPIN(xb_ld(&bar[XB_XGEN(b.x)]) == gen, bar);
            __builtin_amdgcn_fence(__ATOMIC_ACQUIRE, "agent");
            asm volatile("s_waitcnt vmcnt(0)" ::: "memory");
        }
    }
    __syncthreads();
}

template <int MODE>
__device__ __forceinline__ void p0_transpose_item(const float* __restrict__ W, int K, int N, bf16* __restrict__ WT, const float* __restrict__ kscale, LAS float* scr, int item, int lane) {
    const int nblk = N / 32, kb = item / nblk, nb = item % nblk, k0 = 64 * kb, n0 = 32 * nb;
    const int c = lane & 7;
    f32x4 ks0 = {1.f, 1.f, 1.f, 1.f}, ks1 = ks0;
    if (kscale) { ks0 = *(const f32x4*)(kscale + k0 + 8 * c); ks1 = *(const f32x4*)(kscale + k0 + 8 * c + 4); }
    float wv[32];
#pragma unroll
    for (int i = 0; i < 32; ++i) wv[i] = __builtin_nontemporal_load(W + (size_t)(k0 + 2 * i + (lane >> 5)) * N + n0 + (lane & 31));
#pragma unroll
    for (int i = 0; i < 32; ++i) scr[(2 * i + (lane >> 5)) * 33 + (lane & 31)] = wv[i];
    asm volatile("s_waitcnt lgkmcnt(0)" ::: "memory");
#pragma unroll
    for (int j = 0; j < 4; ++j) { const int n = (lane >> 3) + 8 * j; const LAS float* s = scr + (8 * c) * 33 + n;
        u32x4 o; o.x = pk2(s[0 * 33] * ks0[0], s[1 * 33] * ks0[1]); o.y = pk2(s[2 * 33] * ks0[2], s[3 * 33] * ks0[3]); o.z = pk2(s[4 * 33] * ks1[0], s[5 * 33] * ks1[1]); o.w = pk2(s[6 * 33] * ks1[2], s[7 * 33] * ks1[3]);
        const int ng = n0 + n; const int row = (MODE == 0) ? ng : (MODE == 3) ? ((ng & ~255) + 128 * ((ng >> 5) & 1) + 32 * ((ng >> 6) & 3) + (ng & 31)) : (256 * (ng >> 7) + (ng & 127) + (MODE == 2 ? 128 : 0));
        *(u32x4*)(WT + (size_t)row * K + k0 + 8 * c) = o; }
    asm volatile("s_waitcnt lgkmcnt(0)" ::: "memory");
}
__device__ __forceinline__ float wave_sum(float v) {
#pragma unroll
    for (int o = 1; o < 64; o <<= 1) v += __shfl_xor(v, o);
    return v;
}
__device__ __forceinline__ void p0_prologue(const Args& A, LAS unsigned char* lds, int vcu, int G, int wave, int lane) {
    LAS float* scr = (LAS float*)(lds + wave * 16384);
    const int gw = vcu * NWAVES + wave, NGW = G * NWAVES;
    unsigned char* ws = A.ws;
    constexpr int I_IN = (DM / 64) * (DIN / 32), I_OUT = (DM / 64) * (DM / 32), I_G = (DM / 64) * (DFF / 32), I_D = (DFF / 64) * (DM / 32);
    constexpr int NITEMS = I_IN + I_OUT + 2 * I_G + I_D;
    for (int it = gw; it < NITEMS; it += NGW) {
        int r = it;
        if (r < I_IN) { p0_transpose_item<3>(A.w_in, DM, DIN, (bf16*)(ws + WS_WIN), nullptr, scr, r, lane); continue; } r -= I_IN;
        if (r < I_OUT) { p0_transpose_item<0>(A.w_out, DM, DM, (bf16*)(ws + WS_WOUT), nullptr, scr, r, lane); continue; } r -= I_OUT;
        if (r < I_G) { p0_transpose_item<1>(A.w_gate, DM, DFF, (bf16*)(ws + WS_WGU), A.ffn_norm_w, scr, r, lane); continue; } r -= I_G;
        if (r < I_G) { p0_transpose_item<2>(A.w_up, DM, DFF, (bf16*)(ws + WS_WGU), A.ffn_norm_w, scr, r, lane); continue; } r -= I_G;
        p0_transpose_item<0>(A.w_down, DFF, DM, (bf16*)(ws + WS_WD), nullptr, scr, r, lane);
    }
    {
        float* ct = (float*)(ws + WS_ROPE); float* st = ct + SEQ * 32;
        for (int idx = gw * 64 + lane; idx < SEQ * 32; idx += NGW * 64) {
            const int pos = idx >> 5, j = idx & 31;
            const float inv = __builtin_amdgcn_exp2f(-(float)j * (13.287712379549449f / 32.0f));
            const float ang = (float)pos * inv;
            double t = (double)ang * 0.15915494309189535; t -= __builtin_rint(t);
            ct[idx] = __builtin_amdgcn_cosf((float)t); st[idx] = __builtin_amdgcn_sinf((float)t);
        }
    }
    bf16* XN = (bf16*)(ws + WS_XN);
    f32x4 wg[4];
#pragma unroll
    for (int j = 0; j < 4; ++j) wg[j] = ((const f32x4*)A.attn_norm_w)[lane + 64 * j];
    for (int m0 = gw * 4; m0 < TOK; m0 += NGW * 4) {
        f32x4 v[4][4];
#pragma unroll
        for (int u = 0; u < 4; ++u) { const f32x4* xr = (const f32x4*)(A.x + (size_t)(m0 + u) * DM) + lane;
#pragma unroll
            for (int j = 0; j < 4; ++j) v[u][j] = __builtin_nontemporal_load(xr + 64 * j); }
#pragma unroll
        for (int u = 0; u < 4; ++u) { float s = 0.f;
#pragma unroll
            for (int j = 0; j < 4; ++j) s += (v[u][j].x * v[u][j].x + v[u][j].y * v[u][j].y) + (v[u][j].z * v[u][j].z + v[u][j].w * v[u][j].w);
            const float rs = 1.f / sqrtf(wave_sum(s) * (1.f / DM) + EPS);
            u32x2* o8 = (u32x2*)(XN + (size_t)(m0 + u) * DM) + lane;
#pragma unroll
            for (int j = 0; j < 4; ++j) { const f32x4 w = wg[j]; u32x2 o; o.x = pk2(v[u][j].x * rs * w.x, v[u][j].y * rs * w.y); o.y = pk2(v[u][j].z * rs * w.z, v[u][j].w * rs * w.w); o8[64 * j] = o; } }
    }
}

__device__ __forceinline__ void stage_rows(LAS unsigned char* st, const f32x16& o0, const f32x16& o1, float scale, int lane) {
    const int r32 = lane & 31, hi = lane >> 5;
#pragma unroll
    for (int g = 0; g < 4; ++g) {
        u32x2 a, c; a.x = pk2(o0[4 * g] * scale, o0[4 * g + 1] * scale); a.y = pk2(o0[4 * g + 2] * scale, o0[4 * g + 3] * scale); c.x = pk2(o1[4 * g] * scale, o1[4 * g + 1] * scale); c.y = pk2(o1[4 * g + 2] * scale, o1[4 * g + 3] * scale);
        *(LAS u32x2*)(st + r32 * 144 + (8 * g + 4 * hi) * 2) = a; *(LAS u32x2*)(st + r32 * 144 + 64 + (8 * g + 4 * hi) * 2) = c;
    }
    asm volatile("s_waitcnt lgkmcnt(0)" ::: "memory");
}
__device__ __forceinline__ u32x4 staged_chunk(LAS const unsigned char* st, int i, int lane) { return *(LAS const u32x4*)(st + (8 * i + (lane >> 3)) * 144 + (lane & 7) * 16); }

constexpr float SB_EXIT_BITS = 40.f;
template <bool MASK>
__device__ __forceinline__ void sb_tile(f32x16& o0, f32x16& o1, float& carry, const bf16x8 (&qr)[4], LAS const unsigned char* Kb, LAS const unsigned char* Vb, const f16x8& U0, const f16x8& U1, const f16x8& ONES,
                                        int kbase, int trow, int r32, int hi) {
    f32x16 p0 = {}, p1 = {};
    { bf16x8 ka[4], kb[4];
#pragma unroll
      for (int d0 = 0; d0 < 4; ++d0) { ka[d0] = *(LAS const bf16x8*)(Kb + d0 * 2048); kb[d0] = *(LAS const bf16x8*)(Kb + d0 * 2048 + 512); }
#pragma unroll
      for (int d0 = 0; d0 < 4; ++d0) { p0 = MFMA_BF16(ka[d0], qr[d0], p0); p1 = MFMA_BF16(kb[d0], qr[d0], p1); } }
    f32x16 s0, s1;
#pragma unroll
    for (int r = 0; r < 16; ++r) {
        const float z0 = __builtin_fminf(p0[r], 126.f), z1 = __builtin_fminf(p1[r], 126.f);
        p0[r] = z0; p1[r] = z1;
        float a = __builtin_amdgcn_logf(1.f + __builtin_amdgcn_exp2f(z0)), b = __builtin_amdgcn_logf(1.f + __builtin_amdgcn_exp2f(z1));
        if (MASK) { const int key = kbase + (r & 3) + 8 * (r >> 2); if (!(key < trow)) a = 0.f; if (!(key + 32 < trow)) b = 0.f; }
        s0[r] = a; s1[r] = b;
    }
    f16x8 h0a, h0b, h1a, h1b;
#pragma unroll
    for (int i = 0; i < 8; ++i) { h0a[i] = (_Float16)s0[i]; h0b[i] = (_Float16)s0[8 + i]; h1a[i] = (_Float16)s1[i]; h1b[i] = (_Float16)s1[8 + i]; }
    f32x16 ci;
#pragma unroll
    for (int r = 0; r < 16; ++r) ci[r] = carry;
    f32x16 c1 = MFMA_F16(U0, h1a, ci); c1 = MFMA_F16(U1, h1b, c1);
    f32x16 c0 = MFMA_F16(ONES, h1a, ci); c0 = MFMA_F16(ONES, h1b, c0); c0 = MFMA_F16(U0, h0a, c0); c0 = MFMA_F16(U1, h0b, c0);
    carry = __shfl(c0[0], r32);
#pragma unroll
    for (int r = 0; r < 16; ++r) {
        float a = __builtin_amdgcn_exp2f(p0[r] - c0[r]), b = __builtin_amdgcn_exp2f(p1[r] - c1[r]);
        if (MASK) { const int key = kbase + (r & 3) + 8 * (r >> 2); if (!(key < trow)) a = 0.f; if (!(key + 32 < trow)) b = 0.f; }
        p0[r] = a; p1[r] = b;
    }
    u32x4 w[4];
#pragma unroll
    for (int i = 0; i < 4; ++i) { w[0][i] = pk2(p0[2 * i], p0[2 * i + 1]); w[1][i] = pk2(p0[8 + 2 * i], p0[8 + 2 * i + 1]); w[2][i] = pk2(p1[2 * i], p1[2 * i + 1]); w[3][i] = pk2(p1[8 + 2 * i], p1[8 + 2 * i + 1]); }
    bf16x8 va[4], vb4[4];
#pragma unroll
    for (int kk = 0; kk < 4; ++kk) {
        const s16x4 lo = vtr(Vb + kk * 1024), hh = vtr(Vb + kk * 1024 + 512), l2 = vtr(Vb + 4096 + kk * 1024), h2 = vtr(Vb + 4096 + kk * 1024 + 512);
        va[kk] = (bf16x8){lo[0], lo[1], lo[2], lo[3], hh[0], hh[1], hh[2], hh[3]}; vb4[kk] = (bf16x8){l2[0], l2[1], l2[2], l2[3], h2[0], h2[1], h2[2], h2[3]};
    }
#pragma unroll
    for (int kk = 0; kk < 4; ++kk) { const bf16x8 pf = __builtin_bit_cast(bf16x8, w[kk]); o0 = MFMA_BF16(va[kk], pf, o0); o1 = MFMA_BF16(vb4[kk], pf, o1); }
}

constexpr int SB_STAGE = 98304, SB_STAT = 135168;
__device__ __forceinline__ void sb_unit(int b, int h, int qb, const bf16* __restrict__ QKV, bf16* __restrict__ MIX, LAS unsigned char* lds) {
    const int tid = threadIdx.x, lane = tid & 63, r32 = lane & 31, hi = lane >> 5;
    const int wid = __builtin_amdgcn_readfirstlane(tid >> 6);
    const size_t rowbase = (size_t)b * SEQ;
    const int q0 = qb * 256, wrow0 = q0 + wid * 32, trow = wrow0 + r32;
    bf16x8 qr[4];
    { const bf16* Qp = head_base(QKV, 3, b, h) + (size_t)trow * HD + hi * 8;
#pragma unroll
      for (int d0 = 0; d0 < 4; ++d0) qr[d0] = *(const bf16x8*)(Qp + d0 * 16); }
    const bf16* Ksrc = head_base(QKV, 4, b, h) + (size_t)lane * HD + wid * 8;
    const bf16* Vsrc = head_base(QKV, 5, b, h) + (size_t)(16 * (wid & 3) + (lane >> 2)) * HD + (wid >> 2) * 32 + (lane & 3) * 8;
    const int stoff = wid * 1024 + lane * 16;
    const int kt0 = 4 * qb - 2;
    const int kbot = kt0 < 0 ? 0 : kt0;
    { u32x4 kr[6], vr[6];
#pragma unroll
      for (int sl = 0; sl < 6; ++sl) if (kt0 + sl >= 0) { kr[sl] = *(const u32x4*)(Ksrc + (size_t)(kt0 + sl) * 64 * HD); vr[sl] = *(const u32x4*)(Vsrc + (size_t)(kt0 + sl) * 64 * HD); }
#pragma unroll
      for (int sl = 0; sl < 6; ++sl) if (kt0 + sl >= 0) { *(LAS u32x4*)(lds + sl * 16384 + stoff) = kr[sl]; *(LAS u32x4*)(lds + sl * 16384 + 8192 + stoff) = vr[sl]; } }
    f16x8 U0, U1, ONES;
#pragma unroll
    for (int i = 0; i < 8; ++i) { const int j = (i & 3) + 8 * (i >> 2) + 4 * hi; U0[i] = (j >= r32) ? (_Float16)1.f : (_Float16)0.f; U1[i] = (j + 16 >= r32) ? (_Float16)1.f : (_Float16)0.f; ONES[i] = (_Float16)1.f; }
    __syncthreads();
    float carry = 0.f; f32x16 o0 = {}, o1 = {}; bool wfin = false;
    const int kfo = hi * 1024 + r32 * 16;
    const int vbo = ((lane >> 4) & 1) * 32 + (lane & 3) * 8 + (4 * hi + ((lane & 15) >> 2)) * 64;
#pragma unroll 1
    for (int kt = (wrow0 + 30) >> 6; kt >= kbot; --kt) {
        const int sl = kt - kt0;
        LAS const unsigned char* Kb = lds + sl * 16384 + kfo; LAS const unsigned char* Vb = lds + sl * 16384 + 8192 + vbo;
        const int kbase = 64 * kt + 4 * hi;
        if (64 * kt + 63 >= wrow0) sb_tile<true>(o0, o1, carry, qr, Kb, Vb, U0, U1, ONES, kbase, trow, r32, hi);
        else sb_tile<false>(o0, o1, carry, qr, Kb, Vb, U0, U1, ONES, kbase, trow, r32, hi);
        if (__all(carry > SB_EXIT_BITS)) { wfin = true; break; }
    }
    if (kbot == 0) wfin = true;
    LAS unsigned* stat = (LAS unsigned*)(lds + SB_STAT);
    if (lane == 0) stat[16 + wid] = wfin ? 1u : 0u;
    __syncthreads();
    bool alldone;
    { const u32x4 sa = *(LAS const u32x4*)(stat + 16), sb4 = *(LAS const u32x4*)(stat + 20); alldone = (sa.x & sa.y & sa.z & sa.w & sb4.x & sb4.y & sb4.z & sb4.w) != 0u; }
    if (!alldone) {
        const int NT = kt0;
        __syncthreads();
        u32x4 kreg = *(const u32x4*)(Ksrc + (size_t)(NT - 1) * 64 * HD), vreg = *(const u32x4*)(Vsrc + (size_t)(NT - 1) * 64 * HD);
        *(LAS u32x4*)(lds + stoff) = kreg; *(LAS u32x4*)(lds + 16384 + stoff) = vreg;
        __syncthreads();
#pragma unroll 1
        for (int it = 0; it < NT; ++it) {
            const int kt = NT - 1 - it, cur = it & 1;
            const bool more = it + 1 < NT;
            if (more) { kreg = *(const u32x4*)(Ksrc + (size_t)(kt - 1) * 64 * HD); vreg = *(const u32x4*)(Vsrc + (size_t)(kt - 1) * 64 * HD); }
            if (!wfin) {
                LAS const unsigned char* Kb = lds + cur * 8192 + kfo; LAS const unsigned char* Vb = lds + 16384 + cur * 8192 + vbo;
                sb_tile<false>(o0, o1, carry, qr, Kb, Vb, U0, U1, ONES, 64 * kt + 4 * hi, trow, r32, hi);
            }
            if (more) { *(LAS u32x4*)(lds + (cur ^ 1) * 8192 + stoff) = kreg; *(LAS u32x4*)(lds + 16384 + (cur ^ 1) * 8192 + stoff) = vreg; }
            wfin = __all(carry > SB_EXIT_BITS) != 0;
            if (lane == 0) stat[cur * 8 + wid] = wfin ? 1u : 0u;
            __syncthreads();
            const u32x4 sa = *(LAS const u32x4*)(stat + cur * 8), sb4 = *(LAS const u32x4*)(stat + cur * 8 + 4);
            if ((sa.x & sa.y & sa.z & sa.w & sb4.x & sb4.y & sb4.z & sb4.w) != 0u) break;
        }
    }
    { LAS unsigned char* st = lds + SB_STAGE + wid * 4608;
      stage_rows(st, o0, o1, 1.f, lane);
      bf16* Op = MIX + (rowbase + wrow0) * DM + 512 + h * 64 + (lane & 7) * 8;
#pragma unroll
      for (int i = 0; i < 4; ++i) *(u32x4*)(Op + (size_t)(8 * i + (lane >> 3)) * DM) = staged_chunk(st, i, lane);
      asm volatile("s_waitcnt lgkmcnt(0)" ::: "memory"); }
    __syncthreads();
}

struct DilCtx { const bf16* kbase; int lr, c, pb, r32, hi, lane, c8, vst, vbo, kst, kfo; };
constexpr int DIL_KOFF = 4096, DIL_KPITCH = 528, DIL_WL = 8704;
__device__ __forceinline__ void dil_load_group(const DilCtx& X, int G, u32x4 (&kr)[4], u32x4 (&vr)[4]) {
    const int pos0 = 32 * (X.pb - 4 + G);
#pragma unroll
    for (int j = 0; j < 4; ++j) { const bf16* rowp = X.kbase + (size_t)(((pos0 + 8 * j + (X.lane >> 3)) << X.lr) + X.c) * HD + X.c8 * 8;
        kr[j] = *(const u32x4*)rowp; vr[j] = *(const u32x4*)(rowp + SLAB); }
}
template <bool fixed>
__device__ __forceinline__ void dil_step(const DilCtx& X, int G, u32x4 (&kr)[4], u32x4 (&vr)[4], const bf16x8 (&qr)[2][4], f32x16 (&o0)[2], f32x16 (&o1)[2], float (&mrun)[2], float (&lrun)[2], LAS unsigned char* wl) {
    const int r32 = X.r32, hi = X.hi;
#pragma unroll
    for (int j = 0; j < 4; ++j) { *(LAS u32x4*)(wl + X.vst + j * 512) = vr[j]; *(LAS u32x4*)(wl + X.kst + j * 128) = kr[j]; }
    if (G + 1 < 6) dil_load_group(X, G + 1, kr, vr);
    asm volatile("s_waitcnt lgkmcnt(0)" ::: "memory");
    bf16x8 kf[4];
#pragma unroll
    for (int d0 = 0; d0 < 4; ++d0) kf[d0] = *(LAS const bf16x8*)(wl + X.kfo + d0 * (2 * DIL_KPITCH));
#pragma unroll
    for (int u = 0; u < 2; ++u) {
        const int g = G - u;
        if (g >= 0 && g <= 4) {
            f32x16 pp = {};
#pragma unroll
            for (int d0 = 0; d0 < 4; ++d0) pp = MFMA_BF16(kf[d0], qr[u][d0], pp);
            if (g == 0) {
#pragma unroll
                for (int r = 0; r < 16; ++r) if (crow(r, hi) < r32) pp[r] = -INFINITY;
            } else if (g == 4) {
#pragma unroll
                for (int r = 0; r < 16; ++r) if (crow(r, hi) > r32) pp[r] = -INFINITY;
            }
            if (fixed) {
                float ls = 0.f;
#pragma unroll
                for (int r = 0; r < 16; ++r) { pp[r] = __builtin_amdgcn_exp2f(pp[r]); ls += pp[r]; }
                lrun[u] += ls;
            } else {
                float mx = pp[0];
#pragma unroll
                for (int r = 1; r < 16; ++r) mx = __builtin_fmaxf(mx, pp[r]);
                mx = __builtin_fmaxf(mx, __shfl_xor(mx, 32));
                const float mnew = __builtin_fmaxf(mrun[u], mx);
                const float alpha = __builtin_amdgcn_exp2f(mrun[u] - mnew);
                mrun[u] = mnew;
                float ls = 0.f;
#pragma unroll
                for (int r = 0; r < 16; ++r) { pp[r] = __builtin_amdgcn_exp2f(pp[r] - mnew); ls += pp[r]; }
                lrun[u] = lrun[u] * alpha + ls;
#pragma unroll
                for (int r = 0; r < 16; ++r) { o0[u][r] *= alpha; o1[u][r] *= alpha; }
            }
            u32x4 w[2];
#pragma unroll
            for (int i = 0; i < 4; ++i) { w[0][i] = pk2(pp[2 * i], pp[2 * i + 1]); w[1][i] = pk2(pp[8 + 2 * i], pp[8 + 2 * i + 1]); }
            LAS const unsigned char* vb = wl + X.vbo;
            bf16x8 va[2], vc[2];
#pragma unroll
            for (int kk = 0; kk < 2; ++kk) {
                const s16x4 lo = vtr(vb + kk * 1024), hh = vtr(vb + kk * 1024 + 512), l2 = vtr(vb + 2048 + kk * 1024), h2 = vtr(vb + 2048 + kk * 1024 + 512);
                va[kk] = (bf16x8){lo[0], lo[1], lo[2], lo[3], hh[0], hh[1], hh[2], hh[3]}; vc[kk] = (bf16x8){l2[0], l2[1], l2[2], l2[3], h2[0], h2[1], h2[2], h2[3]};
            }
#pragma unroll
            for (int kk = 0; kk < 2; ++kk) { const bf16x8 pf = __builtin_bit_cast(bf16x8, w[kk]); o0[u] = MFMA_BF16(va[kk], pf, o0[u]); o1[u] = MFMA_BF16(vc[kk], pf, o1[u]); }
        }
    }
    asm volatile("s_waitcnt lgkmcnt(0)" ::: "memory");
}
template <bool fixed>
__device__ __forceinline__ void dil_pair(int pairid, const bf16* __restrict__ QKV, bf16* __restrict__ DILO, float* __restrict__ LSE, LAS unsigned char* wl, int lane) {
    const int r32 = lane & 31, hi = lane >> 5;
    const int task = 2 * pairid;
    const int bh = task / 384, rem = task - bh * 384, idx = rem & 127, br = rem >> 7, h = bh & 7;
    const size_t rowbase = (size_t)(bh >> 3) * SEQ, hb = (size_t)bh * (SEQ * HD);
    const int lr = 2 * br;
    const int nbs = 128 >> lr;
    const int c = idx / nbs, pb = idx - c * nbs;
    bf16x8 qr[2][4];
#pragma unroll
    for (int u = 0; u < 2; ++u) {
        const int tq0 = (((32 * (pb + u) + r32) << lr) + c);
        const bf16* Qp = QKV + hb + (size_t)tq0 * HD + hi * 8;
#pragma unroll
        for (int d0 = 0; d0 < 4; ++d0) qr[u][d0] = *(const bf16x8*)(Qp + d0 * 16);
    }
    const int G_lo = (pb < 4) ? (4 - pb) : 0;
    DilCtx X; X.kbase = QKV + SLAB + hb; X.lr = lr; X.c = c; X.pb = pb; X.r32 = r32; X.hi = hi; X.lane = lane; X.c8 = lane & 7;
    X.vst = ((lane & 7) >> 2) * 2048 + (lane >> 3) * 64 + (lane & 3) * 16; X.vbo = ((lane >> 4) & 1) * 32 + (lane & 3) * 8 + (4 * hi + ((lane & 15) >> 2)) * 64;
    X.kst = DIL_KOFF + (lane & 7) * DIL_KPITCH + (lane >> 3) * 16;
    X.kfo = DIL_KOFF + hi * DIL_KPITCH + r32 * 16;
    const float m0 = fixed ? 0.f : -1e30f;
    float mrun[2] = {m0, m0}, lrun[2] = {0.f, 0.f}; f32x16 o0[2] = {}, o1[2] = {};
    u32x4 kr[4], vr[4];
    dil_load_group(X, G_lo, kr, vr);
#pragma unroll 1
    for (int G = G_lo; G < 6; ++G) dil_step<fixed>(X, G, kr, vr, qr, o0, o1, mrun, lrun, wl);
#pragma unroll
    for (int u = 0; u < 2; ++u) {
        const float lt = lrun[u] + __shfl_xor(lrun[u], 32);
        const float inv = __builtin_amdgcn_rcpf(lt);
        const int tqu = (((32 * (pb + u) + r32) << lr) + c);
        stage_rows(wl, o0[u], o1[u], inv, lane);
#pragma unroll
        for (int i = 0; i < 4; ++i) { const int tr = (((32 * (pb + u) + 8 * i + (lane >> 3)) << lr) + c);
            *(u32x4*)(DILO + ((size_t)br * TOK + rowbase + tr) * 512 + h * 64 + (lane & 7) * 8) = staged_chunk(wl, i, lane); }
        asm volatile("s_waitcnt lgkmcnt(0)" ::: "memory");
        if (hi == 0) LSE[((size_t)br * TOK + rowbase + tqu) * 8 + h] = mrun[u] + __builtin_amdgcn_logf(lt);
    }
}

__device__ __forceinline__ void p2c_merge_norm(const Args& A, int vcu, int G, int wave, int lane) {
    const int gw = vcu * NWAVES + wave, NGW = G * NWAVES;
    const bf16* DILO = (const bf16*)(A.ws + WS_DILO); const float* LSE = (const float*)(A.ws + WS_LSE); const bf16* MIX = (const bf16*)(A.ws + WS_MIX); bf16* MIXN = (bf16*)(A.ws + WS_MIXN);
    float wd[8], wsb[8];
#pragma unroll
    for (int i = 0; i < 8; ++i) { wd[i] = A.dil_norm_w[8 * lane + i]; wsb[i] = A.sb_norm_w[8 * lane + i]; }
    for (int m0 = gw * 4; m0 < TOK; m0 += NGW * 4) {
        u32x4 d[4][3], sv[4]; float ls[4][3];
#pragma unroll
        for (int u = 0; u < 4; ++u) { const size_t m = (size_t)(m0 + u);
#pragma unroll
            for (int br = 0; br < 3; ++br) { d[u][br] = __builtin_nontemporal_load((const u32x4*)(DILO + ((size_t)br * TOK + m) * 512 + 8 * lane)); ls[u][br] = LSE[((size_t)br * TOK + m) * 8 + (lane >> 3)]; }
            sv[u] = __builtin_nontemporal_load((const u32x4*)(MIX + m * DM + 512 + 8 * lane)); }
#pragma unroll
        for (int u = 0; u < 4; ++u) {
            const float mx = __builtin_fmaxf(ls[u][0], __builtin_fmaxf(ls[u][1], ls[u][2]));
            float w0 = __builtin_amdgcn_exp2f(ls[u][0] - mx), w1 = __builtin_amdgcn_exp2f(ls[u][1] - mx), w2 = __builtin_amdgcn_exp2f(ls[u][2] - mx);
            const float inv = 1.f / (w0 + w1 + w2); w0 *= inv; w1 *= inv; w2 *= inv;
            float v[8], x[8]; float sd = 0.f, sb = 0.f;
#pragma unroll
            for (int i = 0; i < 4; ++i) {
                v[2 * i] = w0 * bf_lo(d[u][0][i]) + w1 * bf_lo(d[u][1][i]) + w2 * bf_lo(d[u][2][i]); v[2 * i + 1] = w0 * bf_hi(d[u][0][i]) + w1 * bf_hi(d[u][1][i]) + w2 * bf_hi(d[u][2][i]);
                x[2 * i] = bf_lo(sv[u][i]); x[2 * i + 1] = bf_hi(sv[u][i]); }
#pragma unroll
            for (int i = 0; i < 8; ++i) { sd += v[i] * v[i]; sb += x[i] * x[i]; }
            const float rd = 1.f / sqrtf(wave_sum(sd) * (1.f / 512.f) + EPS), rb = 1.f / sqrtf(wave_sum(sb) * (1.f / 512.f) + EPS);
            u32x4 oa, ob;
#pragma unroll
            for (int i = 0; i < 4; ++i) { oa[i] = pk2(v[2 * i] * rd * wd[2 * i], v[2 * i + 1] * rd * wd[2 * i + 1]); ob[i] = pk2(x[2 * i] * rb * wsb[2 * i], x[2 * i + 1] * rb * wsb[2 * i + 1]); }
            bf16* q = MIXN + (size_t)(m0 + u) * DM + 8 * lane;
            *(u32x4*)q = oa; *(u32x4*)(q + 512) = ob;
        }
    }
}

#ifndef REP_P1
#define REP_P1 1
#endif
#ifndef REP_SB
#define REP_SB 1
#endif
#ifndef REP_DIL
#define REP_DIL 1
#endif
#ifndef REP_P0
#define REP_P0 1
#endif
#ifndef REP_P2C
#define REP_P2C 1
#endif
#ifndef REP_P3
#define REP_P3 1
#endif
#ifndef REP_P5
#define REP_P5 1
#endif
#ifndef REP_P4
#define REP_P4 1
#endif
__global__ void __launch_bounds__(NWAVES * 64, 2) hymba_fwd(Args args) {
    extern __shared__ __attribute__((aligned(16))) unsigned char lds_raw[];
    cg::grid_group grid = cg::this_grid();
    LAS unsigned char* lds = (LAS unsigned char*)lds_raw;
    const int tid = threadIdx.x, lane = tid & 63, wave = __builtin_amdgcn_readfirstlane(tid >> 6);
    const int G = gridDim.x; const int bx = blockIdx.x; const int vcu = (G % 8 == 0) ? (bx % 8) * (G / 8) + bx / 8 : bx;
    unsigned char* ws = args.ws;
    const int lo = args.ph_lo, hi = args.ph_hi;
#define IN(k) (lo <= (k) && (k) < hi)
#define SEAM(k) do { if (IN(k)) { if (hi > 1000) grid.sync(); else xcd_barrier(bar); } } while (0)
    if (tid < 64) ((LAS unsigned*)(lds + LDS_BYTES - 256))[tid] = 0u;
    __syncthreads();
    XcdBarrier bar = xcd_barrier_post((unsigned*)(ws + WS_CTL) + 4096, (volatile LAS unsigned*)(lds + LDS_BYTES - 256) + 8);

    if (IN(0)) { for (int rep = 0; rep < REP_P0; ++rep) p0_prologue(args, lds, vcu, G, wave, lane); }
    SEAM(0);
    if (IN(1)) {
#define P1_BODY { pg8::Gemm g{(const pg8::bf16_t*)(ws + WS_XN), (const pg8::bf16_t*)(ws + WS_WIN), TOK, DIN, DM}; pg8::StaticOrder S; S.init(TOK, DIN, G, bx); \
        pg8::EpiQKV E{(pg8::bf16_t*)(ws + WS_QKV), DIN, 2, 4, C_QS / 256, C_QS / 256 + 1, QSCALE, args.q_norm_w, args.k_norm_w, (const float*)(ws + WS_ROPE), (const float*)(ws + WS_ROPE) + SEQ * 32, EPS}; \
        pg8::gemm_phase<pg8::EpiQKV, pg8::StaticOrder, true, true>(lds, g, S, E); }
        P1_BODY
#if REP_P1 == 2
        asm volatile("" ::: "memory");
        P1_BODY
#endif
#undef P1_BODY
    }
    SEAM(1);
    if (IN(3)) {
        const bf16* QKV = (const bf16*)(ws + WS_QKV);
        for (int rep = 0; rep < REP_SB; ++rep)
        for (int v = vcu; v < 256; v += G) {
            const int s = v & 3, bh = v >> 2;
#pragma unroll 1
            for (int i = 0; i < 4; ++i) { const int qb = (i == 0) ? s : (i == 1) ? 7 - s : (i == 2) ? 8 + s : 15 - s; sb_unit(bh >> 3, bh & 7, qb, QKV, (bf16*)(ws + WS_MIX), lds); }
        }
        __syncthreads();
        bool dil_fixed;
        {
            float mq = __builtin_fabsf(args.q_norm_w[lane]), mk = __builtin_fabsf(args.k_norm_w[lane]);
#pragma unroll
            for (int o = 1; o < 64; o <<= 1) { mq = __builtin_fmaxf(mq, __shfl_xor(mq, o)); mk = __builtin_fmaxf(mk, __shfl_xor(mk, o)); }
            dil_fixed = (8.f * 1.4426950408889634f * 1.02f) * mq * mk < 100.f;
        }
        LAS unsigned char* wl = lds + 32768 + wave * DIL_WL;
#define RUN_DIL(FX) do { for (int rep = 0; rep < REP_DIL; ++rep) { const int NW = G * NWAVES, gw = vcu * NWAVES + wave; \
            _Pragma("unroll 1") for (int t = gw; t < 64 * 384 / 2; t += NW) { int pr = t;     \
                if (G == 256) { const int x = gw >> 8, lw = gw & 255, k = t / NW; pr = x * 1536 + ((lw + 37 * k) & 255) + 256 * k; }     \
                dil_pair<FX>(pr, QKV, (bf16*)(ws + WS_DILO), (float*)(ws + WS_LSE), wl, lane); } } } while (0)
        if (dil_fixed) RUN_DIL(true); else RUN_DIL(false);
#undef RUN_DIL
    }
    SEAM(3);
    if (IN(4)) { for (int rep = 0; rep < REP_P2C; ++rep) p2c_merge_norm(args, vcu, G, wave, lane); }
    SEAM(4);
    if (IN(5)) {
        for (int rep = 0; rep < REP_P3; ++rep) {
        pg8::Gemm g{(const pg8::bf16_t*)(ws + WS_MIXN), (const pg8::bf16_t*)(ws + WS_WOUT), TOK, DM, DM}; pg8::StaticOrder S; S.init(TOK, DM, G, bx);
        pg8::EpiRes1 E{args.x, (pg8::bf16_t*)(ws + WS_XN), (float*)(ws + WS_SSQ), DM};
        pg8::gemm_phase<pg8::EpiRes1, pg8::StaticOrder, true, true>(lds, g, S, E);
        }
    }
    SEAM(5);
    if (IN(6)) {
        for (int rep = 0; rep < REP_P4; ++rep) {
        pg8::Gemm g{(const pg8::bf16_t*)(ws + WS_XN), (const pg8::bf16_t*)(ws + WS_WGU), TOK, 2 * DFF, DM}; pg8::StaticOrder S; S.init(TOK, 2 * DFF, G, bx);
        pg8::EpiSwiGLU E{(pg8::bf16_t*)(ws + WS_ACT), DFF, (const float*)(ws + WS_SSQ), 1.f / DM, EPS};
        pg8::gemm_phase<pg8::EpiSwiGLU, pg8::StaticOrder, true, true>(lds, g, S, E);
        }
    }
    SEAM(6);
    if (IN(7)) {
        for (int rep = REP_P5 - 1; rep >= 0; --rep) {
        pg8::Gemm g{(const pg8::bf16_t*)(ws + WS_ACT), (const pg8::bf16_t*)(ws + WS_WD), TOK, DM, DFF}; pg8::StaticOrder S; S.init(TOK, DM, G, bx);
        pg8::EpiRes2 E{(const pg8::bf16_t*)(ws + WS_XN), rep ? (float*)(ws + WS_MIX) : args.out, DM};
        pg8::gemm_phase<pg8::EpiRes2, pg8::StaticOrder, true, true>(lds, g, S, E);
        }
    }
#undef IN
#undef SEAM
}

extern "C" void kernel_launch(void* const* d_in, const int* in_sizes, int n_in, void* d_out, int out_size, void* d_ws, size_t ws_size, hipStream_t stream) {
    static int grid = 0;
    if (grid == 0) {
        if (n_in != 12 || in_sizes[0] != TOK * DM || out_size != TOK * DM || ws_size < WS_END) { fprintf(stderr, "kernel_launch: unexpected shapes / workspace (n_in %d, in0 %d, out %d, ws %zu)\n", n_in, n_in > 0 ? in_sizes[0] : -1, out_size, ws_size); grid = -1; return; }
        int dev = 0, cus = 0, per_cu = 0;
        if (hipGetDevice(&dev) != hipSuccess || hipDeviceGetAttribute(&cus, hipDeviceAttributeMultiprocessorCount, dev) != hipSuccess) { grid = -1; return; }
        if (hipFuncSetAttribute((const void*)hymba_fwd, hipFuncAttributeMaxDynamicSharedMemorySize, LDS_BYTES) != hipSuccess) { fprintf(stderr, "kernel_launch: hipFuncSetAttribute failed\n"); grid = -1; return; }
        if (hipOccupancyMaxActiveBlocksPerMultiprocessor(&per_cu, (const void*)hymba_fwd, NWAVES * 64, LDS_BYTES) != hipSuccess || per_cu < 1) { fprintf(stderr, "kernel_launch: occupancy query says %d blocks per CU\n", per_cu); per_cu = 1; }
        (void)hipGetLastError();
        grid = cus;
    }
    if (grid < 0) return;
    if (hipMemsetAsync((char*)d_ws + WS_CTL, 0, 65536, stream) != hipSuccess) { fprintf(stderr, "kernel_launch: hipMemsetAsync failed\n"); return; }
    Args a{};
    a.x = (const float*)d_in[0]; a.attn_norm_w = (const float*)d_in[1]; a.w_in = (const float*)d_in[2]; a.q_norm_w = (const float*)d_in[3]; a.k_norm_w = (const float*)d_in[4];
    a.dil_norm_w = (const float*)d_in[5]; a.sb_norm_w = (const float*)d_in[6]; a.w_out = (const float*)d_in[7]; a.ffn_norm_w = (const float*)d_in[8];
    a.w_gate = (const float*)d_in[9]; a.w_up = (const float*)d_in[10]; a.w_down = (const float*)d_in[11];
    a.out = (float*)d_out; a.ws = (unsigned char*)d_ws; a.ph_lo = 0; a.ph_hi = 8;
    void* kargs[] = {&a};
    const hipError_t le = hipLaunchCooperativeKernel((const void*)hymba_fwd, dim3(grid), dim3(NWAVES * 64), kargs, LDS_BYTES, stream);
    if (le != hipSuccess) fprintf(stderr, "kernel_launch: cooperative launch failed: %s (grid %d)\n", hipGetErrorName(le), grid);
}
```
